# Optimizing an MI355X kernel written in HIP

```python
import math
import jax, jax.numpy as jnp
from jax import lax
import numpy as np

D_MODEL = 1024
BATCH = 8
SEQ = 4096
DEPTH = 1
DEC_BATCH = 128
DEC_SEQ = 1
PAST_LEN = 16384
PAGE_SIZE = 128

HEAD_DIM = 64
A_HEADS = D_MODEL // HEAD_DIM // 2
B_HEADS = D_MODEL // HEAD_DIM // 2
B_KV_HEADS = 2
B_GROUP = B_HEADS // B_KV_HEADS
A_W = A_HEADS * HEAD_DIM
B_W = B_HEADS * HEAD_DIM
B_KV_W = B_KV_HEADS * HEAD_DIM
IN_SPLITS = (A_W, A_W, A_W, B_W, B_KV_W, B_KV_W)
IN_DIM = sum(IN_SPLITS)
DIL_GROUPS = ((128, 1), (512, 4), (2048, 16))
A_WINDOW = 2048
B_WINDOW = 128
BLOCK = 128
ROPE_THETA = 10000.0
MEM_TOKENS = 256
X_HEADS = 4
X_HEAD_DIM = D_MODEL // X_HEADS
D_FF = ((8 * D_MODEL // 3 + 127) // 128) * 128
CONV_W = 3
EPS = 1e-6
NEG = -1e30

kernel_name = "hybrid_dilated_swa_sink_memory_convffn_step"


def rms_norm(x, g):
    xf = x.astype(jnp.float32)
    y = xf * lax.rsqrt(jnp.mean(xf * xf, axis=-1, keepdims=True) + EPS)
    return (y * g.astype(jnp.float32)).astype(x.dtype)


def rope(x, pos):
    half = HEAD_DIM // 2
    inv = jnp.power(ROPE_THETA, -jnp.arange(half, dtype=jnp.float32) / half)
    ang = pos.astype(jnp.float32)[:, None] * inv[None, :]
    cos = jnp.cos(ang)[:, None, :]
    sin = jnp.sin(ang)[:, None, :]
    xf = x.astype(jnp.float32)
    x1, x2 = xf[..., :half], xf[..., half:]
    return jnp.concatenate([x1 * cos - x2 * sin, x2 * cos + x1 * sin], axis=-1).astype(x.dtype)


def banded_attention(q, k, v, window):
    n, L = q.shape[:2]
    nb = -(-L // BLOCK)
    pad = nb * BLOCK - L
    padl = lambda a: jnp.pad(a, ((0, 0), (0, pad)) + ((0, 0),) * (a.ndim - 2))
    q, k, v = padl(q), padl(k), padl(v)
    qb = q.reshape((n, nb, BLOCK) + q.shape[2:])
    kb = k.reshape((n, nb, BLOCK) + k.shape[2:])
    vb = v.reshape((n, nb, BLOCK) + v.shape[2:])

    def with_prev(a):
        prev = jnp.pad(a, ((0, 0), (1, 0)) + ((0, 0),) * (a.ndim - 2))[:, :-1]
        return jnp.concatenate([prev, a], axis=2)

    kk, vv = with_prev(kb), with_prev(vb)
    scale = q.shape[-1] ** -0.5
    s = jnp.einsum('nbqhgd,nbkhd->nbhgqk', qb, kk, preferred_element_type=jnp.float32) * scale
    qpos = jnp.arange(BLOCK)[:, None] + BLOCK
    kpos = jnp.arange(2 * BLOCK)[None, :]
    dist = qpos - kpos
    band = (dist >= 0) & (dist <= window)
    first = (jnp.arange(nb) == 0)[:, None, None]
    valid = band[None] & ~(first & (kpos < BLOCK)[None])
    s = jnp.where(valid[None, :, None, None], s, NEG)
    lse = jax.nn.logsumexp(s, axis=-1)
    p = jnp.exp(s - lse[..., None])
    o = jnp.einsum('nbhgqk,nbkhd->nbqhgd', p.astype(vv.dtype), vv)
    o = o.reshape((n, nb * BLOCK) + o.shape[3:])[:, :L]
    lse = jnp.moveaxis(lse, 4, 2).reshape((n, nb * BLOCK) + lse.shape[2:4])[:, :L]
    return o, lse


def combine_by_denominator(o, lse, axis):
    w = jax.nn.softmax(lse, axis=axis)
    return jnp.sum(o.astype(jnp.float32) * w[..., None], axis=axis).astype(o.dtype)


def dilated_prompt(q, k, v):
    B, S, H, D = q.shape
    outs, lses = [], []
    for w, d in DIL_GROUPS:
        to_res = lambda a: a.reshape(B, S // d, d, H, D).transpose(0, 2, 1, 3, 4).reshape(B * d, S // d, H, D)
        o, lse = banded_attention(to_res(q)[:, :, :, None], to_res(k), to_res(v), w // d)
        o = o[:, :, :, 0].reshape(B, d, S // d, H, D).transpose(0, 2, 1, 3, 4).reshape(B, S, H, D)
        lse = lse[..., 0].reshape(B, d, S // d, H).transpose(0, 2, 1, 3).reshape(B, S, H)
        outs.append(o)
        lses.append(lse)
    return combine_by_denominator(jnp.stack(outs), jnp.stack(lses), axis=0)


def dilated_sample(q, kc, vc):
    T = q.shape[1]
    L = kc.shape[1] - T
    idx = np.stack([L + np.arange(T)[:, None] - (np.arange(w // d + 1) * d)[None, :] for w, d in DIL_GROUPS])
    valid = jnp.asarray(idx >= 0)
    idx_c = np.maximum(idx, 0)
    kg = kc[:, idx_c]
    vg = vc[:, idx_c]
    s = jnp.einsum('nthd,ngtkhd->ngthk', q, kg, preferred_element_type=jnp.float32) * (HEAD_DIM ** -0.5)
    s = jnp.where(valid[None, :, :, None, :], s, NEG)
    lse = jax.nn.logsumexp(s, axis=-1)
    p = jnp.exp(s - lse[..., None])
    o = jnp.einsum('ngthk,ngtkhd->ngthd', p.astype(vg.dtype), vg)
    return combine_by_denominator(o, lse, axis=1)


def apply_sinks(o, lse, sinks):
    f = jax.nn.sigmoid(lse - sinks.reshape(B_KV_HEADS, B_GROUP).astype(jnp.float32))
    return o * f[..., None].astype(o.dtype)


def swa_sample(q, kc, vc, sinks):
    T = q.shape[1]
    L = kc.shape[1] - T
    dist = jnp.arange(T)[:, None] - (jnp.arange(L + T) - L)[None, :]
    valid = (dist >= 0) & (dist <= B_WINDOW)
    s = jnp.einsum('nthgd,nkhd->nhgtk', q, kc, preferred_element_type=jnp.float32) * (HEAD_DIM ** -0.5)
    s = jnp.where(valid[None, None, None], s, NEG)
    lse = jax.nn.logsumexp(s, axis=-1)
    p = jnp.exp(s - lse[..., None])
    o = jnp.einsum('nhgtk,nkhd->nthgd', p.astype(vc.dtype), vc)
    return apply_sinks(o, jnp.moveaxis(lse, 3, 1), sinks)


def project_mixers(h, w_in, pos):
    N, T, _ = h.shape
    z = h @ w_in
    points = [int(c) for c in np.cumsum(IN_SPLITS)[:-1]]
    qa, ka, va, qb, kb, vb = jnp.split(z, points, axis=-1)
    qa = rope(qa.reshape(N, T, A_HEADS, HEAD_DIM), pos)
    ka = rope(ka.reshape(N, T, A_HEADS, HEAD_DIM), pos)
    va = va.reshape(N, T, A_HEADS, HEAD_DIM)
    qb = rope(qb.reshape(N, T, B_HEADS, HEAD_DIM), pos).reshape(N, T, B_KV_HEADS, B_GROUP, HEAD_DIM)
    kb = rope(kb.reshape(N, T, B_KV_HEADS, HEAD_DIM), pos)
    vb = vb.reshape(N, T, B_KV_HEADS, HEAD_DIM)
    return qa, ka, va, qb, kb, vb


def mixers_out(oa, ob, g_out_a, g_out_b, w_out):
    N, T = oa.shape[:2]
    oa = rms_norm(oa.reshape(N, T, A_W), g_out_a)
    ob = rms_norm(ob.reshape(N, T, B_W), g_out_b)
    return jnp.concatenate([oa, ob], axis=-1) @ w_out


def memory_kv(mem, g_mem, w_mem_kv):
    N, M, _ = mem.shape
    kv = rms_norm(mem, g_mem) @ w_mem_kv
    k, v = jnp.split(kv, 2, axis=-1)
    return k.reshape(N, M, X_HEADS, X_HEAD_DIM), v.reshape(N, M, X_HEADS, X_HEAD_DIM)


def cross_attention(h, mk, mv, w_xq, w_xo):
    N, T, _ = h.shape
    q = (h @ w_xq).reshape(N, T, X_HEADS, X_HEAD_DIM)
    s = jnp.einsum('nthd,nmhd->nhtm', q, mk, preferred_element_type=jnp.float32) * (X_HEAD_DIM ** -0.5)
    p = jax.nn.softmax(s, axis=-1)
    o = jnp.einsum('nhtm,nmhd->nthd', p.astype(mv.dtype), mv).reshape(N, T, D_MODEL)
    return o @ w_xo


def conv_ffn(h, conv_state, w_up, conv_w, conv_b, w_down):
    T = h.shape[1]
    gate, val = jnp.split(h @ w_up, 2, axis=-1)
    gx = jnp.concatenate([conv_state, gate], axis=1)
    conv = conv_b + sum(gx[:, i:i + T] * conv_w[i] for i in range(CONV_W))
    y = (jax.nn.silu(conv) * val) @ w_down
    return y, gx[:, -(CONV_W - 1):]


def prompt_layer(x, mem, g_mix, w_in, g_out_a, g_out_b, sinks, w_out, g_cross, g_mem, w_xq, w_mem_kv, w_xo,
                 g_ffn, w_up, conv_w, conv_b, w_down):
    N, S, _ = x.shape
    pos = jnp.arange(S, dtype=jnp.int32)
    qa, ka, va, qb, kb, vb = project_mixers(rms_norm(x, g_mix), w_in, pos)
    oa = dilated_prompt(qa, ka, va)
    ob, lse_b = banded_attention(qb, kb, vb, B_WINDOW)
    ob = apply_sinks(ob, lse_b, sinks)
    x = x + mixers_out(oa, ob, g_out_a, g_out_b, w_out)
    mk, mv = memory_kv(mem, g_mem, w_mem_kv)
    x = x + cross_attention(rms_norm(x, g_cross), mk, mv, w_xq, w_xo)
    y, conv_state = conv_ffn(rms_norm(x, g_ffn), jnp.zeros((N, CONV_W - 1, D_FF), x.dtype), w_up, conv_w, conv_b, w_down)
    x = x + y
    la, lb = min(A_WINDOW, S), min(B_WINDOW, S)
    return x, (ka[:, S - la:], va[:, S - la:], kb[:, S - lb:], vb[:, S - lb:], mk, mv, conv_state)


def sample_layer(x, a_k, a_v, b_k, b_v, mem_k, mem_v, conv_state, g_mix, w_in, g_out_a, g_out_b, sinks, w_out,
                 g_cross, w_xq, w_xo, g_ffn, w_up, conv_w, conv_b, w_down):
    N, T, _ = x.shape
    pos = PAST_LEN + jnp.arange(T, dtype=jnp.int32)
    qa, ka, va, qb, kb, vb = project_mixers(rms_norm(x, g_mix), w_in, pos)
    kca, vca = jnp.concatenate([a_k, ka], axis=1), jnp.concatenate([a_v, va], axis=1)
    kcb, vcb = jnp.concatenate([b_k, kb], axis=1), jnp.concatenate([b_v, vb], axis=1)
    oa = dilated_sample(qa, kca, vca)
    ob = swa_sample(qb, kcb, vcb, sinks)
    x = x + mixers_out(oa, ob, g_out_a, g_out_b, w_out)
    x = x + cross_attention(rms_norm(x, g_cross), mem_k, mem_v, w_xq, w_xo)
    y, new_conv = conv_ffn(rms_norm(x, g_ffn), conv_state, w_up, conv_w, conv_b, w_down)
    x = x + y
    la, lb = a_k.shape[1], b_k.shape[1]
    return x, (kca[:, -la:], vca[:, -la:], kcb[:, -lb:], vcb[:, -lb:], new_conv)


def setup_inputs(seed: int = 0) -> dict:
    key = jax.random.key(seed)
    ks = iter(jax.random.split(key, 40))
    nrm = lambda shape, scale: jax.random.normal(next(ks), shape, jnp.float32) * scale
    gain = lambda shape: 1.0 + nrm(shape, 0.02)
    la, lb = min(A_WINDOW, PAST_LEN), min(B_WINDOW, PAST_LEN)
    return {
        "x_prompt": nrm((BATCH, SEQ, D_MODEL), 1.0),
        "x_sample": nrm((DEC_BATCH, DEC_SEQ, D_MODEL), 1.0),
        "cache_a_k": nrm((DEPTH, DEC_BATCH, la, A_HEADS, HEAD_DIM), 1.0),
        "cache_a_v": nrm((DEPTH, DEC_BATCH, la, A_HEADS, HEAD_DIM), 1.0),
        "cache_b_k": nrm((DEPTH, DEC_BATCH, lb, B_KV_HEADS, HEAD_DIM), 1.0),
        "cache_b_v": nrm((DEPTH, DEC_BATCH, lb, B_KV_HEADS, HEAD_DIM), 1.0),
        "cache_mem_k": nrm((DEPTH, DEC_BATCH, MEM_TOKENS, X_HEADS, X_HEAD_DIM), 1.0),
        "cache_mem_v": nrm((DEPTH, DEC_BATCH, MEM_TOKENS, X_HEADS, X_HEAD_DIM), 1.0),
        "state_conv": nrm((DEPTH, DEC_BATCH, CONV_W - 1, D_FF), 1.0),
        "mem_prompt": nrm((BATCH, MEM_TOKENS, D_MODEL), 1.0),
        "g_mix": gain((DEPTH, D_MODEL)),
        "w_in": nrm((DEPTH, D_MODEL, IN_DIM), D_MODEL ** -0.5),
        "g_out_a": gain((DEPTH, A_W)),
        "g_out_b": gain((DEPTH, B_W)),
        "sinks": nrm((DEPTH, B_HEADS), 0.5),
        "w_out": nrm((DEPTH, A_W + B_W, D_MODEL), (A_W + B_W) ** -0.5),
        "g_cross": gain((DEPTH, D_MODEL)),
        "g_mem": gain((DEPTH, D_MODEL)),
        "w_xq": nrm((DEPTH, D_MODEL, X_HEADS * X_HEAD_DIM), D_MODEL ** -0.5),
        "w_mem_kv": nrm((DEPTH, D_MODEL, 2 * X_HEADS * X_HEAD_DIM), D_MODEL ** -0.5),
        "w_xo": nrm((DEPTH, X_HEADS * X_HEAD_DIM, D_MODEL), (X_HEADS * X_HEAD_DIM) ** -0.5),
        "g_ffn": gain((DEPTH, D_MODEL)),
        "w_up": nrm((DEPTH, D_MODEL, 2 * D_FF), D_MODEL ** -0.5),
        "conv_w": nrm((DEPTH, CONV_W, D_FF), CONV_W ** -0.5),
        "conv_b": nrm((DEPTH, D_FF), 0.01),
        "w_down": nrm((DEPTH, D_FF, D_MODEL), D_FF ** -0.5),
        "g_final": gain((D_MODEL,)),
    }


def reference(x_prompt, x_sample, cache_a_k, cache_a_v, cache_b_k, cache_b_v, cache_mem_k, cache_mem_v, state_conv,
              mem_prompt, g_mix, w_in, g_out_a, g_out_b, sinks, w_out, g_cross, g_mem, w_xq, w_mem_kv, w_xo,
              g_ffn, w_up, conv_w, conv_b, w_down, g_final):
    hp, hs = x_prompt, x_sample
    p_states, s_states = [], []
    for l in range(DEPTH):
        hp, ps = prompt_layer(hp, mem_prompt, g_mix[l], w_in[l], g_out_a[l], g_out_b[l], sinks[l], w_out[l],
                              g_cross[l], g_mem[l], w_xq[l], w_mem_kv[l], w_xo[l], g_ffn[l], w_up[l], conv_w[l],
                              conv_b[l], w_down[l])
        hs, ss = sample_layer(hs, cache_a_k[l], cache_a_v[l], cache_b_k[l], cache_b_v[l], cache_mem_k[l],
                              cache_mem_v[l], state_conv[l], g_mix[l], w_in[l], g_out_a[l], g_out_b[l], sinks[l],
                              w_out[l], g_cross[l], w_xq[l], w_xo[l], g_ffn[l], w_up[l], conv_w[l], conv_b[l],
                              w_down[l])
        p_states.append(ps)
        s_states.append(ss)
    stack = lambda states, i: jnp.stack([st[i] for st in states])
    y_prompt = rms_norm(hp, g_final)
    y_sample = rms_norm(hs, g_final)
    p_a_k, p_a_v, p_b_k, p_b_v = stack(p_states, 0), stack(p_states, 1), stack(p_states, 2), stack(p_states, 3)
    p_mem_k, p_mem_v, p_conv = stack(p_states, 4), stack(p_states, 5), stack(p_states, 6)
    s_a_k, s_a_v, s_b_k, s_b_v = stack(s_states, 0), stack(s_states, 1), stack(s_states, 2), stack(s_states, 3)
    s_conv = stack(s_states, 4)
    return (y_prompt, y_sample, p_a_k, p_a_v, p_b_k, p_b_v, p_mem_k, p_mem_v, p_conv, s_a_k, s_a_v, s_b_k, s_b_v, s_conv)
```

```cpp
#include <hip/hip_runtime.h>
#include <cstdio>
#include <cstdint>
namespace pg8 {
#define PG8_LAS __attribute__((address_space(3)))
typedef unsigned short bf16_t;
typedef short bf16x8 __attribute__((ext_vector_type(8)));
typedef float f32x4 __attribute__((ext_vector_type(4)));
typedef unsigned u32x4 __attribute__((ext_vector_type(4)));
constexpr int BM = 256, BK = 64, HALF = 128, HTB = HALF * BK * 2  , STAGE_BYTES = 8 * HTB, NXCD = 8, WGM = 8;

__host__ __device__ __forceinline__ int lds_byte(int r, int c) { const int st = (r >> 4) * 2 + (c >> 5), rr = r & 15, cc = c & 31, ob = rr * 64 + cc * 2; return st * 1024 + (ob ^ (((ob >> 9) & 1) << 5)); }
__host__ __device__ __forceinline__ void stage_rc(int b, int& R, int& C) { const int st = b / 1024, sb = b % 1024, swz = sb ^ (((sb >> 9) & 1) << 5); R = (st >> 1) * 16 + swz / 64; C = (st & 1) * 32 + (swz % 64) / 2; }
__host__ __device__ __forceinline__ int perm32(int rho) { const int n = rho >> 4, i = rho & 15; return 8 * (i >> 2) + 4 * n + (i & 3); }

struct Unit { int pm, pn; };
struct Gemm { const bf16_t* A; const bf16_t* Bt; int M, N, K; };

struct StaticOrder {
    int nM, nN, nwg, G, c;
    __host__ __device__ void init(int M, int N, int G_, int c_) { nM = M / BM; nN = N / BM; nwg = nM * nN; G = G_; c = c_; }
    __host__ __device__ bool next(int i, Unit& u) const {
        const long L = (long)i * G + c; if (L >= nwg) return false;
        int wgid = (int)L; { const int q = nwg / NXCD, r = nwg % NXCD, xcd = wgid % NXCD, off = wgid / NXCD; wgid = (xcd < r ? xcd * (q + 1) : r * (q + 1) + (xcd - r) * q) + off; }
        const int nig = WGM * nN, gid = wgid / nig, fm = gid * WGM, gsz = (nM - fm) < WGM ? (nM - fm) : WGM;
        u.pm = fm + ((wgid % nig) % gsz); u.pn = (wgid % nig) / gsz; return true;
    }
    __device__ __forceinline__ void a_ready(const Unit&) const {}
    __device__ __forceinline__ void done(const Unit&) const {}
};

__device__ __forceinline__ unsigned cvt_pk_bf16(float lo, float hi) { unsigned r; asm volatile("v_cvt_pk_bf16_f32 %0, %1, %2" : "=v"(r) : "v"(lo), "v"(hi)); return r; }
typedef float f32x2 __attribute__((ext_vector_type(2)));
typedef unsigned u32x2 __attribute__((ext_vector_type(2)));
namespace shp {
constexpr int D = 1024, NB = 8, S = 4096, MP = NB * S, NS = 128, MT = MP + NS, MPAD = 33024;
constexpr int ZP = 2304, DFF = 2816, UPN = 5632, LA = 2048, LB = 128, MEMT = 256;
constexpr float LOG2E = 1.4426950408889634f;
constexpr float QSCALE64 = 0.125f * LOG2E, QSCALE256 = 0.0625f * LOG2E, EPS = 1e-6f;
constexpr size_t O_YP = 0;
constexpr size_t O_YS = O_YP + (size_t)MP * D;
constexpr size_t O_PAK = O_YS + (size_t)NS * D;
constexpr size_t O_PAV = O_PAK + (size_t)NB * LA * 512;
constexpr size_t O_PBK = O_PAV + (size_t)NB * LA * 512;
constexpr size_t O_PBV = O_PBK + (size_t)NB * LB * 128;
constexpr size_t O_PMK = O_PBV + (size_t)NB * LB * 128;
constexpr size_t O_PMV = O_PMK + (size_t)NB * MEMT * 1024;
constexpr size_t O_PCV = O_PMV + (size_t)NB * MEMT * 1024;
constexpr size_t O_SAK = O_PCV + (size_t)NB * 2 * DFF;
constexpr size_t O_SAV = O_SAK + (size_t)NS * LA * 512;
constexpr size_t O_SBK = O_SAV + (size_t)NS * LA * 512;
constexpr size_t O_SBV = O_SBK + (size_t)NS * LB * 128;
constexpr size_t O_SCV = O_SBV + (size_t)NS * LB * 128;
constexpr size_t O_END = O_SCV + (size_t)NS * 2 * DFF;
}
struct EpiInProj {
    static constexpr bool PERM = true, AFTER_DRAIN = false;
    bf16_t* Z; float* out;
    __device__ __forceinline__ void operator()(const f32x4 (&acc)[2][2][4][2], const Unit& u, int wr, int wc, int fr, int fq) const {
        using namespace shp;
        const int ct = u.pn * BM;
        const int d0 = 16 * (wc & 1) + 4 * fq;
        float inv[4];
#pragma unroll
        for (int i = 0; i < 4; ++i) inv[i] = __builtin_amdgcn_exp2f(-(float)(d0 + i) * (13.287712379549449f / 32.0f)) * 0.15915494309189535f;
#pragma unroll
        for (int ai = 0; ai < 2; ++ai)
#pragma unroll
            for (int m = 0; m < 4; ++m) {
                const int r = u.pm * BM + ai * HALF + wr * 64 + m * 16 + fr;
                const bool prompt = r < MP, sample = (r >= MP) && (r < MT);
                const int t = r & (S - 1), b = r >> 12, n = r - MP;
                const float pos = prompt ? (float)t : 16384.0f;
                float cs[4], sn[4];
#pragma unroll
                for (int i = 0; i < 4; ++i) { float rev = pos * inv[i]; rev -= __builtin_floorf(rev); cs[i] = __builtin_amdgcn_cosf(rev); sn[i] = __builtin_amdgcn_sinf(rev); }
                bf16_t* zrow = Z + (size_t)r * ZP;
#pragma unroll
                for (int bj = 0; bj < 2; ++bj) {
                    const int cb = ct + bj * HALF + wc * 32 + 8 * fq;
                    const int hb = cb & ~63;
                    const f32x4 a0 = acc[ai][bj][m][0], a1 = acc[ai][bj][m][1];
                    const bool is_v = (ct == 1024) || (ct == 1280) || (ct == 2048 && bj == 1);
                    if (is_v) {
                        u32x4 w; w.x = cvt_pk_bf16(a0[0], a0[1]); w.y = cvt_pk_bf16(a0[2], a0[3]); w.z = cvt_pk_bf16(a1[0], a1[1]); w.w = cvt_pk_bf16(a1[2], a1[3]);
                        *(u32x4*)(zrow + cb) = w;
                        float* so = nullptr;
                        if (ct < 2048) { const int c = cb - 1024;
                            if (prompt && t >= S - LA) so = out + O_PAV + ((size_t)b * LA + (t - (S - LA))) * 512 + c;
                            else if (sample) so = out + O_SAV + ((size_t)n * LA + (LA - 1)) * 512 + c;
                        } else { const int c = cb - 2176;
                            if (prompt && t >= S - LB) so = out + O_PBV + ((size_t)b * LB + (t - (S - LB))) * 128 + c;
                            else if (sample) so = out + O_SBV + ((size_t)n * LB + (LB - 1)) * 128 + c;
                        }
                        if (so) { *(f32x4*)so = a0; *(f32x4*)(so + 4) = a1; }
                    } else {
                        const bool is_q = (ct < 512) || (ct >= 1536 && ct < 2048);
                        const float x1[4] = {a0[0], a0[2], a1[0], a1[2]}, x2[4] = {a0[1], a0[3], a1[1], a1[3]};
                        float o1[4], o2[4];
#pragma unroll
                        for (int i = 0; i < 4; ++i) { o1[i] = x1[i] * cs[i] - x2[i] * sn[i]; o2[i] = x2[i] * cs[i] + x1[i] * sn[i]; }
                        if (is_q) {
#pragma unroll
                            for (int i = 0; i < 4; ++i) { o1[i] *= QSCALE64; o2[i] *= QSCALE64; }
                        }
                        u32x2 lo, hi; lo.x = cvt_pk_bf16(o1[0], o1[1]); lo.y = cvt_pk_bf16(o1[2], o1[3]); hi.x = cvt_pk_bf16(o2[0], o2[1]); hi.y = cvt_pk_bf16(o2[2], o2[3]);
                        *(u32x2*)(zrow + hb + d0) = lo; *(u32x2*)(zrow + hb + 32 + d0) = hi;
                        if (!is_q) {
                            float* so = nullptr;
                            if (ct < 2048) { const int c = hb - 512 + d0;
                                if (prompt && t >= S - LA) so = out + O_PAK + ((size_t)b * LA + (t - (S - LA))) * 512 + c;
                                else if (sample) so = out + O_SAK + ((size_t)n * LA + (LA - 1)) * 512 + c;
                            } else { const int c = hb - 2048 + d0;
                                if (prompt && t >= S - LB) so = out + O_PBK + ((size_t)b * LB + (t - (S - LB))) * 128 + c;
                                else if (sample) so = out + O_SBK + ((size_t)n * LB + (LB - 1)) * 128 + c;
                            }
                            if (so) { *(f32x4*)so = (f32x4){o1[0], o1[1], o1[2], o1[3]}; *(f32x4*)(so + 32) = (f32x4){o2[0], o2[1], o2[2], o2[3]}; }
                        }
                    }
                }
            }
    }
};
struct EpiMemKV {
    static constexpr bool PERM = true, AFTER_DRAIN = false;
    bf16_t* MK; bf16_t* MV; float* out;
    __device__ __forceinline__ void operator()(const f32x4 (&acc)[2][2][4][2], const Unit& u, int wr, int wc, int fr, int fq) const {
        using namespace shp;
        const bool isv = u.pn >= 4; const int ct = (u.pn & 3) * BM;
        bf16_t* B = isv ? MV : MK; float* O = out + (isv ? O_PMV : O_PMK);
#pragma unroll
        for (int ai = 0; ai < 2; ++ai)
#pragma unroll
            for (int m = 0; m < 4; ++m) { const size_t r = (size_t)(u.pm * BM + ai * HALF + wr * 64 + m * 16 + fr);
#pragma unroll
                for (int bj = 0; bj < 2; ++bj) { const int c = ct + bj * HALF + wc * 32 + 8 * fq; const f32x4 a0 = acc[ai][bj][m][0], a1 = acc[ai][bj][m][1];
                    u32x4 w; w.x = cvt_pk_bf16(a0[0], a0[1]); w.y = cvt_pk_bf16(a0[2], a0[3]); w.z = cvt_pk_bf16(a1[0], a1[1]); w.w = cvt_pk_bf16(a1[2], a1[3]);
                    *(u32x4*)(B + r * 1024 + c) = w; *(f32x4*)(O + r * 1024 + c) = a0; *(f32x4*)(O + r * 1024 + c + 4) = a1; } }
    }
};
template <bool FIRST> struct EpiResid {
    static constexpr bool PERM = false, AFTER_DRAIN = false;
    const float* xp; const float* xs;
    float* xres; bf16_t* xb; float* ssq;
    __device__ __forceinline__ void operator()(const f32x4 (&acc)[2][2][4][2], const Unit& u, int wr, int wc, int fr, int fq) const {
        using namespace shp;
#pragma unroll
        for (int ai = 0; ai < 2; ++ai)
#pragma unroll
            for (int m = 0; m < 4; ++m) { const int r = u.pm * BM + ai * HALF + wr * 64 + m * 16 + fr;
                const float* src = FIRST ? (r < MP ? xp + (size_t)r * D : xs + (size_t)(r - MP) * D) : xres + (size_t)r * D;
                const bool ok = r < MT; float q = 0.f;
#pragma unroll
                for (int bj = 0; bj < 2; ++bj)
#pragma unroll
                    for (int n = 0; n < 2; ++n) { const int c = u.pn * BM + bj * HALF + wc * 32 + n * 16 + 4 * fq;
                        f32x4 v = acc[ai][bj][m][n];
                        if (ok) v = v + *(const f32x4*)(src + c);
                        q += (v[0] * v[0] + v[1] * v[1]) + (v[2] * v[2] + v[3] * v[3]);
                        if (ok) { *(f32x4*)(xres + (size_t)r * D + c) = v;
                            if (xb) { u32x2 w; w.x = cvt_pk_bf16(v[0], v[1]); w.y = cvt_pk_bf16(v[2], v[3]); *(u32x2*)(xb + (size_t)r * D + c) = w; } } }
                q += __shfl_xor(q, 16); q += __shfl_xor(q, 32);
                if (fq == 0) ssq[(size_t)r * 16 + u.pn * 4 + wc] = q; }
    }
};
struct EpiScaleBf16 {
    static constexpr bool PERM = true, AFTER_DRAIN = false;
    bf16_t* O; int ldc; const float* ssq; float scale;
    __device__ __forceinline__ void operator()(const f32x4 (&acc)[2][2][4][2], const Unit& u, int wr, int wc, int fr, int fq) const {
        using namespace shp;
#pragma unroll
        for (int ai = 0; ai < 2; ++ai)
#pragma unroll
            for (int m = 0; m < 4; ++m) { const size_t r = (size_t)(u.pm * BM + ai * HALF + wr * 64 + m * 16 + fr);
                const f32x4 s0 = *(const f32x4*)(ssq + r * 16), s1 = *(const f32x4*)(ssq + r * 16 + 4), s2 = *(const f32x4*)(ssq + r * 16 + 8), s3 = *(const f32x4*)(ssq + r * 16 + 12);
                const f32x4 st = (s0 + s1) + (s2 + s3); const float tot = (st[0] + st[1]) + (st[2] + st[3]);
                const float sc = __builtin_amdgcn_rsqf(tot * (1.0f / D) + EPS) * scale;
#pragma unroll
                for (int bj = 0; bj < 2; ++bj) { const int c = u.pn * BM + bj * HALF + wc * 32 + 8 * fq; const f32x4 a0 = acc[ai][bj][m][0] * sc, a1 = acc[ai][bj][m][1] * sc;
                    u32x4 w; w.x = cvt_pk_bf16(a0[0], a0[1]); w.y = cvt_pk_bf16(a0[2], a0[3]); w.z = cvt_pk_bf16(a1[0], a1[1]); w.w = cvt_pk_bf16(a1[2], a1[3]);
                    *(u32x4*)(O + r * ldc + c) = w; } }
    }
};
template <class Epi, class Sched, bool ALIGN_EPI = false, bool SP2 = false>
__device__ __forceinline__ void gemm_phase(PG8_LAS unsigned char* lds, const Gemm g, const Sched& S, const Epi& E) {
    const int tid = threadIdx.x, wid = __builtin_amdgcn_readfirstlane(tid >> 6), lane = tid & 63, wr = wid >> 2, wc = wid & 3, fr = lane & 15, fq = lane >> 4;
    const int K = g.K, nt = K / BK;
    unsigned voffA[2], voffB[2];
#pragma unroll
    for (int i = 0; i < 2; ++i) { int R, C; stage_rc(tid * 16 + i * 8192, R, C); const int Rb = Epi::PERM ? ((R & ~31) + perm32(R & 31)) : R;
        voffA[i] = (unsigned)(R * K + C) * 2u; voffB[i] = (unsigned)(Rb * K + C) * 2u; }
    const size_t kstep = (size_t)(BK * 2);
    const size_t hstep = (size_t)HALF * K * 2;
    const size_t tstep = 2 * hstep;
    const unsigned ldsw = (unsigned)wid * 1024u;
    const int aoff = lds_byte(wr * 64 + fr, fq * 8), boff = lds_byte(wc * 32 + fr, fq * 8);
#define PG8_SA(b, h) (((b) * 2 + (h)) * HTB)
#define PG8_SB(b, h) ((4 + (b) * 2 + (h)) * HTB)
#define PG8_STAGE(bufoff, gbase, voff) do { _Pragma("unroll") for (int _i = 0; _i < 2; ++_i) \
        __builtin_amdgcn_global_load_lds((const unsigned*)((const char*)(gbase) + (voff)[_i]), (PG8_LAS unsigned*)(lds + (bufoff) + ldsw + _i * 8192), 16, 0, 0); } while (0)
#define PG8_LDA(dst, b, h) do { _Pragma("unroll") for (int m = 0; m < 4; ++m) _Pragma("unroll") for (int k = 0; k < 2; ++k) dst[m][k] = *(const PG8_LAS bf16x8*)(lds + PG8_SA(b, h) + aoff + m * 2048 + k * 1024); } while (0)
#define PG8_LDB(dst, b, h) do { _Pragma("unroll") for (int n = 0; n < 2; ++n) _Pragma("unroll") for (int k = 0; k < 2; ++k) dst[n][k] = *(const PG8_LAS bf16x8*)(lds + PG8_SB(b, h) + boff + n * 2048 + k * 1024); } while (0)
#define PG8_MMA(ai, bj, At, Bt) do { __builtin_amdgcn_s_setprio(1); _Pragma("unroll") for (int m = 0; m < 4; ++m) _Pragma("unroll") for (int n = 0; n < 2; ++n) _Pragma("unroll") for (int k = 0; k < 2; ++k) \
        acc[ai][bj][m][n] = __builtin_amdgcn_mfma_f32_16x16x32_bf16(Bt[n][k], At[m][k], acc[ai][bj][m][n], 0, 0, 0); __builtin_amdgcn_s_setprio(0); } while (0)
#define PG8_WAIT_V(n) asm volatile("s_waitcnt vmcnt(" #n ")" ::: "memory")
#define PG8_WAIT_L(n) asm volatile("s_waitcnt lgkmcnt(" #n ")" ::: "memory")
#define PG8_BAR __builtin_amdgcn_s_barrier()
#define PG8_SCHED __builtin_amdgcn_sched_barrier(0)
    Unit cur, nxt; int ui = 0;
    if (!S.next(0, cur)) return;
    f32x4 acc[2][2][4][2];
#pragma unroll
    for (int a = 0; a < 2; ++a)
#pragma unroll
        for (int b = 0; b < 2; ++b)
#pragma unroll
            for (int m = 0; m < 4; ++m)
#pragma unroll
                for (int n = 0; n < 2; ++n) acc[a][b][m][n] = (f32x4){0.f, 0.f, 0.f, 0.f};
    bf16x8 At[4][2], B0[2][2], B1[2][2];
    const char* cA = (const char*)g.A + (size_t)cur.pm * tstep; const char* cB = (const char*)g.Bt + (size_t)cur.pn * tstep;
    S.a_ready(cur);
    if constexpr (SP2) {
        PG8_STAGE(PG8_SB(0, 0), cB, voffB); PG8_STAGE(PG8_SB(0, 1), cB + hstep, voffB); PG8_STAGE(PG8_SA(0, 0), cA, voffA); PG8_STAGE(PG8_SA(0, 1), cA + hstep, voffA);
        if (wr == 1) PG8_BAR;
        PG8_WAIT_V(2); PG8_BAR;
        PG8_STAGE(PG8_SB(1, 0), cB + kstep, voffB); PG8_STAGE(PG8_SA(1, 0), cA + kstep, voffA); PG8_STAGE(PG8_SB(1, 1), cB + hstep + kstep, voffB);
        PG8_WAIT_V(6); PG8_BAR;
    } else {
        PG8_STAGE(PG8_SB(0, 0), cB, voffB); PG8_STAGE(PG8_SA(0, 0), cA, voffA); PG8_STAGE(PG8_SB(0, 1), cB + hstep, voffB); PG8_STAGE(PG8_SA(0, 1), cA + hstep, voffA);
        if (wr == 1) PG8_BAR;
        PG8_WAIT_V(4); PG8_BAR;
        PG8_STAGE(PG8_SB(1, 0), cB + kstep, voffB); PG8_STAGE(PG8_SA(1, 0), cA + kstep, voffA); PG8_STAGE(PG8_SB(1, 1), cB + hstep + kstep, voffB);
        PG8_WAIT_V(6); PG8_BAR;
    }
    for (;;) {
        const bool has_next = S.next(ui + 1, nxt);
        const char* nA = has_next ? (const char*)g.A + (size_t)nxt.pm * tstep : cA; const char* nB = has_next ? (const char*)g.Bt + (size_t)nxt.pn * tstep : cB;
        for (int t = 0; t < nt; t += 2) {
            const bool last = (t == nt - 2);
            const char* a1 = cA + (size_t)(t + 1) * kstep;
            const char* a2 = last ? nA : cA + (size_t)(t + 2) * kstep; const char* b2 = last ? nB : cB + (size_t)(t + 2) * kstep;
            const char* a3 = a2 + kstep; const char* b3 = b2 + kstep;
            if (last && has_next) S.a_ready(nxt);
            if constexpr (SP2) {
            PG8_LDB(B0, 0, 0); PG8_LDB(B1, 0, 1); PG8_SCHED; PG8_LDA(At, 0, 0); PG8_STAGE(PG8_SA(1, 1), a1 + hstep, voffA);
            PG8_WAIT_V(8); PG8_WAIT_L(0); PG8_BAR; PG8_MMA(0, 0, At, B0); PG8_MMA(0, 1, At, B1); PG8_BAR; PG8_SCHED;
            PG8_LDA(At, 0, 1); PG8_STAGE(PG8_SB(0, 0), b2, voffB); PG8_STAGE(PG8_SB(0, 1), b2 + hstep, voffB); PG8_STAGE(PG8_SA(0, 0), a2, voffA);
            PG8_WAIT_V(8); PG8_WAIT_L(0); PG8_BAR; PG8_MMA(1, 0, At, B0); PG8_MMA(1, 1, At, B1); PG8_BAR; PG8_SCHED;
            PG8_LDB(B0, 1, 0); PG8_LDB(B1, 1, 1); PG8_SCHED; PG8_LDA(At, 1, 0); PG8_STAGE(PG8_SA(0, 1), a2 + hstep, voffA);
            PG8_WAIT_V(8); PG8_WAIT_L(0); PG8_BAR; PG8_MMA(0, 0, At, B0); PG8_MMA(0, 1, At, B1); PG8_BAR; PG8_SCHED;
            PG8_LDA(At, 1, 1); PG8_STAGE(PG8_SB(1, 0), b3, voffB); PG8_STAGE(PG8_SB(1, 1), b3 + hstep, voffB); PG8_STAGE(PG8_SA(1, 0), a3, voffA);
            PG8_WAIT_V(8); PG8_WAIT_L(0); PG8_BAR; PG8_MMA(1, 0, At, B0); PG8_MMA(1, 1, At, B1); PG8_BAR; PG8_SCHED;
            } else {
            PG8_LDB(B0, 0, 0); PG8_SCHED; PG8_LDA(At, 0, 0); PG8_STAGE(PG8_SA(1, 1), a1 + hstep, voffA);
            PG8_WAIT_L(8); PG8_BAR; PG8_WAIT_L(0); PG8_MMA(0, 0, At, B0); PG8_BAR; PG8_SCHED;
            PG8_LDB(B1, 0, 1); PG8_STAGE(PG8_SB(0, 0), b2, voffB);
            PG8_BAR; PG8_WAIT_L(0); PG8_MMA(0, 1, At, B1); PG8_BAR;
            PG8_LDA(At, 0, 1); PG8_STAGE(PG8_SA(0, 0), a2, voffA);
            PG8_BAR; PG8_WAIT_L(0); PG8_MMA(1, 0, At, B0); PG8_BAR; PG8_SCHED;
            PG8_STAGE(PG8_SB(0, 1), b2 + hstep, voffB);
            PG8_WAIT_V(6); PG8_BAR; PG8_MMA(1, 1, At, B1); PG8_BAR;
            PG8_LDB(B0, 1, 0); PG8_SCHED; PG8_LDA(At, 1, 0); PG8_STAGE(PG8_SA(0, 1), a2 + hstep, voffA);
            PG8_WAIT_L(8); PG8_BAR; PG8_WAIT_L(0); PG8_MMA(0, 0, At, B0); PG8_BAR; PG8_SCHED;
            PG8_LDB(B1, 1, 1); PG8_STAGE(PG8_SB(1, 0), b3, voffB);
            PG8_BAR; PG8_WAIT_L(0); PG8_MMA(0, 1, At, B1); PG8_BAR;
            PG8_LDA(At, 1, 1); PG8_STAGE(PG8_SA(1, 0), a3, voffA);
            PG8_BAR; PG8_WAIT_L(0); PG8_MMA(1, 0, At, B0); PG8_BAR; PG8_SCHED;
            PG8_STAGE(PG8_SB(1, 1), b3 + hstep, voffB);
            PG8_WAIT_V(6); PG8_BAR; PG8_MMA(1, 1, At, B1); PG8_BAR;
            }
        }
        if constexpr (ALIGN_EPI) { if (wr == 0) PG8_BAR; }
        if constexpr (!Epi::AFTER_DRAIN) { E(acc, cur, wr, wc, fr, fq); S.done(cur); }
        if (!has_next) break;
#pragma unroll
        for (int a = 0; a < 2; ++a)
#pragma unroll
            for (int b = 0; b < 2; ++b)
#pragma unroll
                for (int m = 0; m < 4; ++m)
#pragma unroll
                    for (int n = 0; n < 2; ++n) acc[a][b][m][n] = (f32x4){0.f, 0.f, 0.f, 0.f};
        cur = nxt; cA = nA; cB = nB; ++ui;
        if constexpr (ALIGN_EPI) { if (wr == 1) PG8_BAR; }
    }
    PG8_WAIT_V(0);
    if constexpr (!ALIGN_EPI) { if (wr == 0) PG8_BAR; }
    PG8_BAR;
    if constexpr (Epi::AFTER_DRAIN) { E.fused(acc, cur, wr, wc, fr, fq, lds, wid, lane); S.done(cur); }
#undef PG8_SA
#undef PG8_SB
#undef PG8_STAGE
#undef PG8_LDA
#undef PG8_LDB
#undef PG8_MMA
#undef PG8_WAIT_V
#undef PG8_WAIT_L
#undef PG8_BAR
#undef PG8_SCHED
}
}
#define GAS __attribute__((address_space(1)))
#define LAS __attribute__((address_space(3)))
typedef unsigned short bf16;
typedef unsigned v4u __attribute__((ext_vector_type(4)));
typedef float f32x4 __attribute__((ext_vector_type(4)));
typedef short bf16x8 __attribute__((ext_vector_type(8)));
typedef GAS unsigned gu32;
typedef GAS unsigned long long gu64;
#define RLX_AGENT __ATOMIC_RELAXED, __HIP_MEMORY_SCOPE_AGENT
#define LDS_WAIT() asm volatile("s_waitcnt lgkmcnt(0)" ::: "memory")
#define VM_WAIT() asm volatile("s_waitcnt vmcnt(0)" ::: "memory")
__device__ __forceinline__ unsigned long long rt() { return __builtin_amdgcn_s_memrealtime(); }
__device__ __forceinline__ unsigned f2bf(float f) { unsigned u = __builtin_bit_cast(unsigned, f); return (u + 0x7fffu + ((u >> 16) & 1u)) >> 16; }
__device__ __forceinline__ unsigned pk2(float lo, float hi) { return f2bf(lo) | (f2bf(hi) << 16); }

#define XB_TMO      128
#define XB_XCNT(j)  (256  + 64 * (j))
#define XB_XSUB(j)  (1280 + 64 * (j))
#define XB_XGEN(j)  (2304 + 64 * (j))
#define XB_TOP      3328
#define XB_TOPGEN   3392
#define XCD_BAR_WORDS 3456
#define XB_SPIN_CAP (1u << 18)

__device__ __forceinline__ unsigned xb_ld(unsigned* p)              { return __hip_atomic_load(p, __ATOMIC_RELAXED, __HIP_MEMORY_SCOPE_AGENT); }
__device__ __forceinline__ unsigned xb_add(unsigned* p, unsigned v) { return __hip_atomic_fetch_add(p, v, __ATOMIC_RELAXED, __HIP_MEMORY_SCOPE_AGENT); }
__device__ __forceinline__ unsigned xb_xcc_id() { return (unsigned)__builtin_amdgcn_s_getreg((3 << 11) | 20) & 0xFu; }
#define XB_SPIN(cond, bar) do { unsigned _sp = 0; while (cond) { __builtin_amdgcn_s_sleep(1); \
    if ((++_sp & 255u) == 0u) { if (xb_ld(&(bar)[XB_TMO])) break; if (_sp > XB_SPIN_CAP) { atomicAdd(&(bar)[XB_TMO], 1u); break; } } } } while (0)

struct XcdBarrier {
    unsigned* bar; unsigned x;
    volatile LAS unsigned* st;
};

__device__ __forceinline__ XcdBarrier xcd_barrier_post(unsigned* bar, volatile LAS unsigned* st) {
    XcdBarrier b; b.bar = bar; b.x = xb_xcc_id(); b.st = st;
    if (threadIdx.x == 0) (void)xb_add(&bar[XB_XCNT(b.x)], 1u);
    return b;
}
__device__ __forceinline__ void xcd_barrier_complete(unsigned* bar, unsigned x, unsigned& nloc, unsigned& nx) {
    const unsigned G = gridDim.x * gridDim.y * gridDim.z;
    unsigned sum, cnt, mine, sp = 0u;
    for (;;) {
        sum = 0u; cnt = 0u; mine = 0u;
#pragma unroll
        for (unsigned j = 0; j < 16; ++j) { const unsigned c = xb_ld(&bar[XB_XCNT(j)]); sum += c; cnt += (c > 0u) ? 1u : 0u; mine = (j == x) ? c : mine; }
        if (sum == G) break;
        __builtin_amdgcn_s_sleep(1);
        if ((++sp & 255u) == 0u) { if (xb_ld(&bar[XB_TMO])) break; if (sp > XB_SPIN_CAP) { atomicAdd(&bar[XB_TMO], 1u); break; } }
    }
    nloc = mine > 0u ? mine : 1u; nx = cnt > 0u ? cnt : 1u;
}

__device__ __forceinline__ void xcd_barrier(const XcdBarrier& b) {
    asm volatile("s_waitcnt vmcnt(0)" ::: "memory");
    __syncthreads();
    if (threadIdx.x == 0) {
        unsigned* bar = b.bar;
        __builtin_amdgcn_s_waitcnt(0);
        unsigned nloc = b.st[0], nx = b.st[1];
        if (nloc == 0u) { xcd_barrier_complete(bar, b.x, nloc, nx); b.st[0] = nloc; b.st[1] = nx; }
        const unsigned old = xb_add(&bar[XB_XSUB(b.x)], 1u);
        const unsigned gen = old / nloc;
        if (old + 1u == (gen + 1u) * nloc) {
            __builtin_amdgcn_fence(__ATOMIC_RELEASE, "agent");
            asm volatile("s_waitcnt vmcnt(0)" ::: "memory");
            const unsigned og = xb_add(&bar[XB_TOP], 1u);
            const unsigned tg = og / nx;
            if (og + 1u == (tg + 1u) * nx) xb_add(&bar[XB_TOPGEN], 1u);
            else XB_SPIN(xb_ld(&bar[XB_TOPGEN]) == tg, bar);
            __builtin_amdgcn_fence(__ATOMIC_ACQUIRE, "agent");
            xb_add(&bar[XB_XGEN(b.x)], 1u);
            asm volatile("s_waitcnt vmcnt(0)" ::: "memory");
        } else {
            XB_SPIN(xb_ld(&bar[XB_XGEN(b.x)]) == gen, bar);
            __builtin_amdgcn_fence(__ATOMIC_ACQUIRE, "agent");
            asm volatile("s_waitcnt vmcnt(0)" ::: "memory");
        }
    }
    __syncthreads();
}
using namespace pg8::shp;
constexpr int NWAVES = 8;
#ifndef MK_N_LAUNCHES
#define MK_N_LAUNCHES 12
#endif
constexpr int NPH = 12;
constexpr int N_LAUNCHES = MK_N_LAUNCHES;
constexpr size_t MiB = 1u << 20;
constexpr size_t WS_CTL = 0, CTL_ZERO_BYTES = 1 * MiB;
constexpr size_t WS_WIN = 2 * MiB, WS_WOUT = 7 * MiB, WS_WXQ = 9 * MiB, WS_WMKV = 11 * MiB, WS_WXO = 15 * MiB, WS_WUP = 17 * MiB, WS_WDN = 28 * MiB;
constexpr size_t WS_MEMN = 34 * MiB, WS_MK = 38 * MiB, WS_MV = 42 * MiB, WS_SSQ1 = 46 * MiB, WS_SSQ2 = 49 * MiB, WS_SSQ3 = 52 * MiB, WS_SO = 55 * MiB, WS_PL = 56 * MiB;
constexpr size_t WS_XN = 64 * MiB, WS_Z = 130 * MiB, WS_PO = 276 * MiB, WS_OB = 372 * MiB, WS_OC = 404 * MiB, WS_XRES = 470 * MiB, WS_QX = 600 * MiB, WS_OX = 665 * MiB;
constexpr size_t WS_GV = 730 * MiB, WS_ACT = 1085 * MiB, WS_END = 1264 * MiB;
constexpr int CW_BAR = 4096;
constexpr int RING_BYTES = 131072, LDSCTL_OFF = RING_BYTES, MISC_OFF = LDSCTL_OFF + 320, LDS_BYTES = 147456;

typedef float f32x16 __attribute__((ext_vector_type(16)));
typedef short s16x4 __attribute__((ext_vector_type(4)));
typedef short v4i16_t __attribute__((ext_vector_type(4)));
typedef unsigned u32x2v __attribute__((ext_vector_type(2)));
struct Frame {
    LAS unsigned char* lds;
    volatile LAS unsigned* MISC;
    gu32* ctl;
    int tid, lane, wave, vcu, G;
    const float *x_prompt, *x_sample, *cache_a_k, *cache_a_v, *cache_b_k, *cache_b_v, *cache_mem_k, *cache_mem_v, *state_conv, *mem_prompt;
    const float *g_mix, *w_in, *g_out_a, *g_out_b, *sinks, *w_out, *g_cross, *g_mem, *w_xq, *w_mem_kv, *w_xo, *g_ffn, *w_up, *conv_w, *conv_b, *w_down, *g_final;
    float* out;
    bf16 *WIN, *WOUT, *WXQ, *WMKV, *WXO, *WUP, *WDN;
    bf16 *MEMN, *MK, *MV, *XN, *Z, *PO, *OB, *OC, *QX, *OX, *GV, *ACT;
    float *SSQ1, *SSQ2, *SSQ3, *SO, *PL, *XRES;
};
__device__ __forceinline__ float wave_sum(float v) {
#pragma unroll
    for (int o = 1; o < 64; o <<= 1) v += __shfl_xor(v, o);
    return v;
}
__device__ __forceinline__ float bf2f(unsigned short h) { return __builtin_bit_cast(float, (unsigned)h << 16); }
__device__ __forceinline__ float bflo(unsigned w) { return __builtin_bit_cast(float, w << 16); }
__device__ __forceinline__ float bfhi(unsigned w) { return __builtin_bit_cast(float, w & 0xffff0000u); }
__device__ __forceinline__ int crow(int r, int hi) { return (r & 3) + 8 * (r >> 2) + 4 * hi; }
__device__ __forceinline__ s16x4 vtr(LAS const unsigned char* p) { return __builtin_bit_cast(s16x4, __builtin_amdgcn_ds_read_tr16_b64_v4i16((LAS v4i16_t*)p)); }
constexpr float NEGBIG = -1.0e30f;

__device__ __forceinline__ int drow_of(int n, int mode) {
    if (mode == 1 && (n < 1024 || (n >= 1536 && n < 2176))) { const int dd = n & 63; return (n & ~63) + (dd < 32 ? 2 * dd : 2 * (dd - 32) + 1); }
    return n;
}
__device__ __forceinline__ void p0_transpose_item(const float* W, int K, int N, bf16* WT, const float* ga, const float* gb, int gsplit, int mode, LAS float* scr, int item, int lane) {
    const int nblk = N / 32, kb = item / nblk, nb = item % nblk, k0 = 64 * kb, n0 = 32 * nb;
#pragma unroll 8
    for (int i = 0; i < 32; ++i) { const int kk = 2 * i + (lane >> 5); const int k = k0 + kk;
        float g = 1.0f; if (ga) g = (k < gsplit) ? ga[k] : gb[k - gsplit];
        scr[kk * 33 + (lane & 31)] = W[(size_t)k * N + n0 + (lane & 31)] * g; }
    LDS_WAIT(); asm volatile("" ::: "memory");
    const int c = lane & 7;
#pragma unroll
    for (int j = 0; j < 4; ++j) { const int n = (lane >> 3) + 8 * j; const LAS float* s = scr + (8 * c) * 33 + n;
        v4u o; o.x = pk2(s[0 * 33], s[1 * 33]); o.y = pk2(s[2 * 33], s[3 * 33]); o.z = pk2(s[4 * 33], s[5 * 33]); o.w = pk2(s[6 * 33], s[7 * 33]);
        *(GAS v4u*)(WT + (size_t)drow_of(n0 + n, mode) * K + k0 + 8 * c) = o; }
    LDS_WAIT(); asm volatile("" ::: "memory");
}
__device__ __forceinline__ void rms_row_to_bf16(int lane, const float* xrow, bf16* orow) {
    const GAS f32x4* xr = (const GAS f32x4*)xrow + lane;
    f32x4 v[4]; float s = 0.f;
#pragma unroll
    for (int j = 0; j < 4; ++j) { v[j] = xr[64 * j]; s += (v[j].x * v[j].x + v[j].y * v[j].y) + (v[j].z * v[j].z + v[j].w * v[j].w); }
    const float rstd = 1.f / sqrtf(wave_sum(s) * (1.f / D) + EPS);
    GAS unsigned long long* o8 = (GAS unsigned long long*)orow + lane;
#pragma unroll
    for (int j = 0; j < 4; ++j) o8[64 * j] = (unsigned long long)pk2(v[j].x * rstd, v[j].y * rstd) | ((unsigned long long)pk2(v[j].z * rstd, v[j].w * rstd) << 32);
}
__device__ __forceinline__ void copy_shift(const float* src, float* dst, int nb, int rows, int rowf, long gtid, long gthreads) {
    const long per = (long)(rows - 1) * rowf / 4, tot = per * nb;
    for (long i = gtid; i < tot; i += gthreads) { const long n = i / per, off = i - n * per;
        const f32x4 v = __builtin_nontemporal_load((const f32x4*)(src + (size_t)n * rows * rowf + rowf) + off);
        __builtin_nontemporal_store(v, (f32x4*)(dst + (size_t)n * rows * rowf) + off); }
}
__device__ __forceinline__ void p0_prologue(Frame& F) {
    LAS float* scr = (LAS float*)(F.lds + F.wave * 16384);
    const int gw = F.vcu * NWAVES + F.wave, NGW = F.G * NWAVES;
    constexpr int I_IN = 16 * 72, I_OUT = 16 * 32, I_XQ = 16 * 32, I_MKV = 16 * 64, I_XO = 16 * 32, I_UP = 16 * 176, I_DN = 44 * 32;
    constexpr int NITEMS = I_IN + I_OUT + I_XQ + I_MKV + I_XO + I_UP + I_DN;
    for (int it = gw; it < NITEMS; it += NGW) {
        int r = it;
        if (r < I_IN) { p0_transpose_item(F.w_in, 1024, 2304, F.WIN, F.g_mix, F.g_mix, 1024, 1, scr, r, F.lane); continue; } r -= I_IN;
        if (r < I_OUT) { p0_transpose_item(F.w_out, 1024, 1024, F.WOUT, F.g_out_a, F.g_out_b, 512, 0, scr, r, F.lane); continue; } r -= I_OUT;
        if (r < I_XQ) { p0_transpose_item(F.w_xq, 1024, 1024, F.WXQ, F.g_cross, F.g_cross, 1024, 0, scr, r, F.lane); continue; } r -= I_XQ;
        if (r < I_MKV) { p0_transpose_item(F.w_mem_kv, 1024, 2048, F.WMKV, F.g_mem, F.g_mem, 1024, 0, scr, r, F.lane); continue; } r -= I_MKV;
        if (r < I_XO) { p0_transpose_item(F.w_xo, 1024, 1024, F.WXO, nullptr, nullptr, 0, 0, scr, r, F.lane); continue; } r -= I_XO;
        if (r < I_UP) { p0_transpose_item(F.w_up, 1024, 5632, F.WUP, F.g_ffn, F.g_ffn, 1024, 0, scr, r, F.lane); continue; } r -= I_UP;
        p0_transpose_item(F.w_down, 2816, 1024, F.WDN, nullptr, nullptr, 0, 0, scr, r, F.lane);
    }
    for (int m = gw; m < MT + NB * MEMT; m += NGW) {
        if (m < MP) rms_row_to_bf16(F.lane, F.x_prompt + (size_t)m * D, F.XN + (size_t)m * D);
        else if (m < MT) rms_row_to_bf16(F.lane, F.x_sample + (size_t)(m - MP) * D, F.XN + (size_t)m * D);
        else rms_row_to_bf16(F.lane, F.mem_prompt + (size_t)(m - MT) * D, F.MEMN + (size_t)(m - MT) * D);
    }
    const long gtid = (long)F.vcu * (NWAVES * 64) + F.tid, gthreads = (long)F.G * (NWAVES * 64);
    copy_shift(F.cache_a_k, F.out + O_SAK, NS, LA, 512, gtid, gthreads);
    copy_shift(F.cache_a_v, F.out + O_SAV, NS, LA, 512, gtid, gthreads);
    copy_shift(F.cache_b_k, F.out + O_SBK, NS, LB, 128, gtid, gthreads);
    copy_shift(F.cache_b_v, F.out + O_SBV, NS, LB, 128, gtid, gthreads);
    copy_shift(F.state_conv, F.out + O_SCV, NS, 2, DFF, gtid, gthreads);
}

template <bool IS_B>
__device__ __forceinline__ void swa_unit(Frame& F, int kind, int b, int h, int d, int rho, int i0) {
    const int lane = F.lane, r32 = lane & 31, hi = lane >> 5;
    const int qcol = IS_B ? 1536 + h * 64 : h * 64, kcol = IS_B ? 2048 + (h >> 2) * 64 : 512 + h * 64, vcol = IS_B ? 2176 + (h >> 2) * 64 : 1024 + h * 64;
    const bf16* Zb = F.Z + (size_t)b * S * ZP;
    const int tq = rho + d * (i0 + r32);
    bf16x8 qf[4];
#pragma unroll
    for (int s = 0; s < 4; ++s) qf[s] = *(const bf16x8*)(Zb + (size_t)tq * ZP + qcol + 16 * s + 8 * hi);
    f32x16 sc[5];
#pragma unroll
    for (int kt = 0; kt < 5; ++kt) {
        const int jbase = i0 + 32 * kt - 128;
        f32x16 a;
#pragma unroll
        for (int i = 0; i < 16; ++i) a[i] = 0.f;
        if (jbase + 31 >= 0) {
            int jr = jbase + r32; jr = jr < 0 ? 0 : jr;
            const bf16* kp = Zb + (size_t)(rho + d * jr) * ZP + kcol + 8 * hi;
#pragma unroll
            for (int s = 0; s < 4; ++s) a = __builtin_amdgcn_mfma_f32_32x32x16_bf16(*(const bf16x8*)(kp + 16 * s), qf[s], a, 0, 0, 0);
#pragma unroll
            for (int i = 0; i < 16; ++i) { const int kr = crow(i, hi), kprime = 32 * kt + kr - 128;
                const bool valid = (kprime <= r32) && (r32 - kprime <= 128) && (jbase + kr >= 0);
                a[i] = valid ? a[i] : NEGBIG; }
        } else {
#pragma unroll
            for (int i = 0; i < 16; ++i) a[i] = NEGBIG;
        }
        sc[kt] = a;
    }
    float m = NEGBIG;
#pragma unroll
    for (int kt = 0; kt < 5; ++kt)
#pragma unroll
        for (int i = 0; i < 16; ++i) m = fmaxf(m, sc[kt][i]);
    m = fmaxf(m, __shfl_xor(m, 32));
    float l = 0.f;
#pragma unroll
    for (int kt = 0; kt < 5; ++kt)
#pragma unroll
        for (int i = 0; i < 16; ++i) { const float p = __builtin_amdgcn_exp2f(sc[kt][i] - m); sc[kt][i] = p; l += p; }
    l += __shfl_xor(l, 32);
    bf16x8 pa[5][2];
#pragma unroll
    for (int kt = 0; kt < 5; ++kt)
#pragma unroll
        for (int s2 = 0; s2 < 2; ++s2) { v4u w;
            w.x = pg8::cvt_pk_bf16(sc[kt][8 * s2 + 0], sc[kt][8 * s2 + 1]); w.y = pg8::cvt_pk_bf16(sc[kt][8 * s2 + 2], sc[kt][8 * s2 + 3]);
            w.z = pg8::cvt_pk_bf16(sc[kt][8 * s2 + 4], sc[kt][8 * s2 + 5]); w.w = pg8::cvt_pk_bf16(sc[kt][8 * s2 + 6], sc[kt][8 * s2 + 7]);
            pa[kt][s2] = __builtin_bit_cast(bf16x8, w); }
    LAS unsigned char* vbuf = F.lds + F.wave * 8192;
    const int laneoff = (4 * hi + ((lane & 15) >> 2)) * 64 + ((lane >> 4) & 1) * 32 + (lane & 3) * 8;
    f32x16 o[2];
#pragma unroll
    for (int i = 0; i < 16; ++i) { o[0][i] = 0.f; o[1][i] = 0.f; }
#pragma unroll
    for (int kt = 0; kt < 5; ++kt) {
        const int jbase = i0 + 32 * kt - 128;
        if (jbase + 31 >= 0) {
            LAS unsigned char* buf = vbuf + (kt & 1) * 4096;
#pragma unroll
            for (int i = 0; i < 4; ++i) { const int idx = lane + 64 * i, key = idx >> 3, ch = idx & 7; int jr = jbase + key; jr = jr < 0 ? 0 : jr;
                const v4u v = *(const v4u*)(Zb + (size_t)(rho + d * jr) * ZP + vcol + ch * 8);
                *(LAS v4u*)(buf + (ch >> 2) * 2048 + (key >> 4) * 1024 + (key & 15) * 64 + (ch & 3) * 16) = v; }
#pragma unroll
            for (int d0 = 0; d0 < 2; ++d0)
#pragma unroll
                for (int s2 = 0; s2 < 2; ++s2) { const s16x4 lo = vtr(buf + d0 * 2048 + s2 * 1024 + laneoff), hh = vtr(buf + d0 * 2048 + s2 * 1024 + 512 + laneoff);
                    const bf16x8 vf = (bf16x8){lo[0], lo[1], lo[2], lo[3], hh[0], hh[1], hh[2], hh[3]};
                    o[d0] = __builtin_amdgcn_mfma_f32_32x32x16_bf16(pa[kt][s2], vf, o[d0], 0, 0, 0); }
        }
    }
    float linv = 1.0f / l; const float lse2 = m + __builtin_amdgcn_logf(l);
    if (IS_B) linv *= 1.0f / (1.0f + __builtin_amdgcn_exp2f(F.sinks[h] * LOG2E - lse2));
    bf16* dst = IS_B ? F.OB + (size_t)b * S * 512 + h * 64 : F.PO + (size_t)kind * MP * 512 + (size_t)b * S * 512 + h * 64;
#pragma unroll
    for (int i = 0; i < 16; ++i) { const int qrow = crow(i, hi); const float li = __shfl(linv, qrow); const int tqo = rho + d * (i0 + qrow);
#pragma unroll
        for (int d0 = 0; d0 < 2; ++d0) dst[(size_t)tqo * 512 + 32 * d0 + r32] = (bf16)f2bf(o[d0][i] * li); }
    if (!IS_B && hi == 0) F.PL[(size_t)kind * MP * 8 + ((size_t)b * S + tq) * 8 + h] = lse2;
}
__device__ __forceinline__ void sample_attn_unit(Frame& F, int su) {
    const int lane = F.lane, li = lane & 15, lg = lane >> 4;
    const bool isB = su >= 1024; const int n = (su & 1023) >> 3, hh = su & 7;
    const bf16* zrow = F.Z + (size_t)(MP + n) * ZP;
    int qcol, kcol, vcol, rs; const float *Kc, *Vc;
    if (!isB) { qcol = hh * 64; kcol = 512 + hh * 64; vcol = 1024 + hh * 64; rs = 512; Kc = F.cache_a_k + (size_t)n * LA * 512 + hh * 64; Vc = F.cache_a_v + (size_t)n * LA * 512 + hh * 64; }
    else { const int g = hh >> 2; qcol = 1536 + hh * 64; kcol = 2048 + g * 64; vcol = 2176 + g * 64; rs = 128; Kc = F.cache_b_k + (size_t)n * LB * 128 + g * 64; Vc = F.cache_b_v + (size_t)n * LB * 128 + g * 64; }
    float q4[4], kn[4], vn[4];
    { const u32x2v a = *(const u32x2v*)(zrow + qcol + 4 * li), k2 = *(const u32x2v*)(zrow + kcol + 4 * li), v2 = *(const u32x2v*)(zrow + vcol + 4 * li);
      q4[0] = bflo(a.x); q4[1] = bfhi(a.x); q4[2] = bflo(a.y); q4[3] = bfhi(a.y);
      kn[0] = bflo(k2.x); kn[1] = bfhi(k2.x); kn[2] = bflo(k2.y); kn[3] = bfhi(k2.y);
      vn[0] = bflo(v2.x); vn[1] = bfhi(v2.x); vn[2] = bflo(v2.y); vn[3] = bfhi(v2.y); }
    LAS float* scs = (LAS float*)(F.lds + F.wave * 8192);
    const int nseg = isB ? 1 : 3;
    float mx = NEGBIG;
    for (int seg = 0; seg < nseg; ++seg) { const int step = 1 << (2 * seg);
#pragma unroll 8
        for (int it = 0; it < 32; ++it) { const int j = 4 * it + lg; const int row = isB ? j : (LA - step * (j + 1));
            const f32x4 kv = *(const f32x4*)(Kc + (size_t)row * rs + 4 * li);
            float s = (q4[0] * kv[0] + q4[1] * kv[1]) + (q4[2] * kv[2] + q4[3] * kv[3]);
            s += __shfl_xor(s, 1); s += __shfl_xor(s, 2); s += __shfl_xor(s, 4); s += __shfl_xor(s, 8);
            if (li == 0) scs[seg * 128 + j] = s;
            mx = fmaxf(mx, s); } }
    float snew = (q4[0] * kn[0] + q4[1] * kn[1]) + (q4[2] * kn[2] + q4[3] * kn[3]);
    snew += __shfl_xor(snew, 1); snew += __shfl_xor(snew, 2); snew += __shfl_xor(snew, 4); snew += __shfl_xor(snew, 8);
    mx = fmaxf(mx, snew); mx = fmaxf(mx, __shfl_xor(mx, 16)); mx = fmaxf(mx, __shfl_xor(mx, 32));
    LDS_WAIT(); asm volatile("" ::: "memory");
    float o4[4] = {0.f, 0.f, 0.f, 0.f}, l = 0.f;
    for (int seg = 0; seg < nseg; ++seg) { const int step = 1 << (2 * seg);
#pragma unroll 8
        for (int it = 0; it < 32; ++it) { const int j = 4 * it + lg; const int row = isB ? j : (LA - step * (j + 1));
            const float p = __builtin_amdgcn_exp2f(scs[seg * 128 + j] - mx); l += p;
            const f32x4 vv = *(const f32x4*)(Vc + (size_t)row * rs + 4 * li);
            o4[0] += p * vv[0]; o4[1] += p * vv[1]; o4[2] += p * vv[2]; o4[3] += p * vv[3]; } }
#pragma unroll
    for (int c = 0; c < 4; ++c) { o4[c] += __shfl_xor(o4[c], 16); o4[c] += __shfl_xor(o4[c], 32); }
    l += __shfl_xor(l, 16); l += __shfl_xor(l, 32);
    const float pn = (isB ? 1.0f : 3.0f) * __builtin_amdgcn_exp2f(snew - mx);
    l += pn;
#pragma unroll
    for (int c = 0; c < 4; ++c) o4[c] += pn * vn[c];
    float scale = 1.0f / l;
    if (isB) { const float lse2 = mx + __builtin_amdgcn_logf(l); scale *= 1.0f / (1.0f + __builtin_amdgcn_exp2f(F.sinks[hh] * LOG2E - lse2)); }
    if (lg == 0) *(f32x4*)(F.SO + (size_t)n * 1024 + (isB ? 512 : 0) + hh * 64 + 4 * li) = (f32x4){o4[0] * scale, o4[1] * scale, o4[2] * scale, o4[3] * scale};
    LDS_WAIT(); asm volatile("" ::: "memory");
}
__device__ __forceinline__ void p2_attention(Frame& F) {
    const int gw = F.vcu * NWAVES + F.wave, NGW = F.G * NWAVES;
    for (int u = gw; u < 4 * 8192; u += NGW) {
        const int kind = u >> 13, rem = u & 8191, b = rem >> 10, r2 = rem & 1023, h = r2 >> 7, r3 = r2 & 127;
        if (kind == 3) swa_unit<true>(F, 3, b, h, 1, 0, r3 * 32);
        else { const int d = 1 << (2 * kind), nblk = 128 >> (2 * kind), rho = r3 / nblk, blk = r3 % nblk; swa_unit<false>(F, kind, b, h, d, rho, blk * 32); }
    }
    for (int su = gw; su < 2048; su += NGW) sample_attn_unit(F, su);
}
__device__ __forceinline__ void p3_mix(Frame& F) {
    const int gw = F.vcu * NWAVES + F.wave, NGW = F.G * NWAVES, lane = F.lane;
    for (int r = gw; r < MT; r += NGW) {
        float a[8], bb[8];
        if (r < MP) {
            const int head = lane >> 3;
            float ls[3], mxl = NEGBIG;
#pragma unroll
            for (int k = 0; k < 3; ++k) { ls[k] = F.PL[(size_t)k * MP * 8 + (size_t)r * 8 + head]; mxl = fmaxf(mxl, ls[k]); }
            float w[3], ws = 0.f;
#pragma unroll
            for (int k = 0; k < 3; ++k) { w[k] = __builtin_amdgcn_exp2f(ls[k] - mxl); ws += w[k]; }
            const float wi = 1.0f / ws;
#pragma unroll
            for (int e = 0; e < 8; ++e) a[e] = 0.f;
#pragma unroll
            for (int k = 0; k < 3; ++k) { const v4u v = *(const v4u*)(F.PO + (size_t)k * MP * 512 + (size_t)r * 512 + lane * 8); const float wk = w[k] * wi;
                a[0] += wk * bflo(v.x); a[1] += wk * bfhi(v.x); a[2] += wk * bflo(v.y); a[3] += wk * bfhi(v.y); a[4] += wk * bflo(v.z); a[5] += wk * bfhi(v.z); a[6] += wk * bflo(v.w); a[7] += wk * bfhi(v.w); }
            const v4u v = *(const v4u*)(F.OB + (size_t)r * 512 + lane * 8);
            bb[0] = bflo(v.x); bb[1] = bfhi(v.x); bb[2] = bflo(v.y); bb[3] = bfhi(v.y); bb[4] = bflo(v.z); bb[5] = bfhi(v.z); bb[6] = bflo(v.w); bb[7] = bfhi(v.w);
        } else {
            const float* so = F.SO + (size_t)(r - MP) * 1024 + lane * 8;
            const f32x4 a0 = *(const f32x4*)so, a1 = *(const f32x4*)(so + 4), b0 = *(const f32x4*)(so + 512), b1 = *(const f32x4*)(so + 516);
            a[0] = a0[0]; a[1] = a0[1]; a[2] = a0[2]; a[3] = a0[3]; a[4] = a1[0]; a[5] = a1[1]; a[6] = a1[2]; a[7] = a1[3];
            bb[0] = b0[0]; bb[1] = b0[1]; bb[2] = b0[2]; bb[3] = b0[3]; bb[4] = b1[0]; bb[5] = b1[1]; bb[6] = b1[2]; bb[7] = b1[3];
        }
        float sa = 0.f, sb = 0.f;
#pragma unroll
        for (int e = 0; e < 8; ++e) { sa += a[e] * a[e]; sb += bb[e] * bb[e]; }
        const float ra = 1.0f / sqrtf(wave_sum(sa) * (1.0f / 512.0f) + EPS), rb = 1.0f / sqrtf(wave_sum(sb) * (1.0f / 512.0f) + EPS);
        v4u oa, ob;
        oa.x = pk2(a[0] * ra, a[1] * ra); oa.y = pk2(a[2] * ra, a[3] * ra); oa.z = pk2(a[4] * ra, a[5] * ra); oa.w = pk2(a[6] * ra, a[7] * ra);
        ob.x = pk2(bb[0] * rb, bb[1] * rb); ob.y = pk2(bb[2] * rb, bb[3] * rb); ob.z = pk2(bb[4] * rb, bb[5] * rb); ob.w = pk2(bb[6] * rb, bb[7] * rb);
        *(v4u*)(F.OC + (size_t)r * D + lane * 8) = oa; *(v4u*)(F.OC + (size_t)r * D + 512 + lane * 8) = ob;
    }
}
__device__ __forceinline__ void cross_unit(Frame& F, int b, int hx, int qb) {
    const int lane = F.lane, r32 = lane & 31, hi = lane >> 5;
    const size_t qrow0 = (size_t)b * S + qb * 256 + F.wave * 32;
    const bf16* Qp = F.QX + (qrow0 + r32) * 1024 + hx * 256 + 8 * hi;
    bf16x8 qf[16];
#pragma unroll
    for (int s = 0; s < 16; ++s) qf[s] = *(const bf16x8*)(Qp + 16 * s);
    f32x16 sc[8];
#pragma unroll
    for (int kt = 0; kt < 8; ++kt) {
        const bf16* kp = F.MK + (size_t)(b * 256 + 32 * kt + r32) * 1024 + hx * 256 + 8 * hi;
        f32x16 a;
#pragma unroll
        for (int i = 0; i < 16; ++i) a[i] = 0.f;
#pragma unroll
        for (int s = 0; s < 16; ++s) a = __builtin_amdgcn_mfma_f32_32x32x16_bf16(*(const bf16x8*)(kp + 16 * s), qf[s], a, 0, 0, 0);
        sc[kt] = a;
    }
    float m = NEGBIG;
#pragma unroll
    for (int kt = 0; kt < 8; ++kt)
#pragma unroll
        for (int i = 0; i < 16; ++i) m = fmaxf(m, sc[kt][i]);
    m = fmaxf(m, __shfl_xor(m, 32));
    float l = 0.f;
    bf16x8 pa[8][2];
#pragma unroll
    for (int kt = 0; kt < 8; ++kt) {
#pragma unroll
        for (int i = 0; i < 16; ++i) { const float p = __builtin_amdgcn_exp2f(sc[kt][i] - m); sc[kt][i] = p; l += p; }
#pragma unroll
        for (int s2 = 0; s2 < 2; ++s2) { v4u w;
            w.x = pg8::cvt_pk_bf16(sc[kt][8 * s2 + 0], sc[kt][8 * s2 + 1]); w.y = pg8::cvt_pk_bf16(sc[kt][8 * s2 + 2], sc[kt][8 * s2 + 3]);
            w.z = pg8::cvt_pk_bf16(sc[kt][8 * s2 + 4], sc[kt][8 * s2 + 5]); w.w = pg8::cvt_pk_bf16(sc[kt][8 * s2 + 6], sc[kt][8 * s2 + 7]);
            pa[kt][s2] = __builtin_bit_cast(bf16x8, w); }
    }
    l += __shfl_xor(l, 32);
    const float linv = 1.0f / l;
    const int laneoff = (4 * hi + ((lane & 15) >> 2)) * 64 + ((lane >> 4) & 1) * 32 + (lane & 3) * 8;
    bf16* Op = F.OX + qrow0 * 1024 + hx * 256;
#pragma unroll 1
    for (int d0 = 0; d0 < 8; ++d0) {
        f32x16 o;
#pragma unroll
        for (int i = 0; i < 16; ++i) o[i] = 0.f;
        LAS const unsigned char* vb = F.lds + d0 * 16384 + laneoff;
#pragma unroll
        for (int kt = 0; kt < 8; ++kt)
#pragma unroll
            for (int s2 = 0; s2 < 2; ++s2) { const int ks = 2 * kt + s2; const s16x4 lo = vtr(vb + ks * 1024), hh = vtr(vb + ks * 1024 + 512);
                const bf16x8 vf = (bf16x8){lo[0], lo[1], lo[2], lo[3], hh[0], hh[1], hh[2], hh[3]};
                o = __builtin_amdgcn_mfma_f32_32x32x16_bf16(pa[kt][s2], vf, o, 0, 0, 0); }
#pragma unroll
        for (int i = 0; i < 16; ++i) { const int qrow = crow(i, hi); const float li = __shfl(linv, qrow);
            Op[(size_t)qrow * 1024 + 32 * d0 + r32] = (bf16)f2bf(o[i] * li); }
    }
}
__device__ __forceinline__ void cross_load_v(Frame& F, int b, int hx) {
#pragma unroll 4
    for (int i = 0; i < 16; ++i) { const int idx = F.tid + 512 * i, key = idx >> 5, ch = idx & 31;
        const v4u v = *(const v4u*)(F.MV + (size_t)(b * 256 + key) * 1024 + hx * 256 + ch * 8);
        *(LAS v4u*)(F.lds + (ch >> 2) * 16384 + (key >> 4) * 1024 + (key & 15) * 64 + (ch & 3) * 16) = v; }
}
__device__ __forceinline__ void cross_sample_unit(Frame& F, int n, int hx) {
    const int lane = F.lane, w = F.wave;
    LAS float* scs = (LAS float*)F.lds;
    LAS float* part = (LAS float*)(F.lds + 1024);
    float q4[4];
    { const u32x2v a = *(const u32x2v*)(F.QX + (size_t)(MP + n) * 1024 + hx * 256 + 4 * lane); q4[0] = bflo(a.x); q4[1] = bfhi(a.x); q4[2] = bflo(a.y); q4[3] = bfhi(a.y); }
    const float* Kc = F.cache_mem_k + ((size_t)n * MEMT * 4 + hx) * 256 + 4 * lane;
    const float* Vc = F.cache_mem_v + ((size_t)n * MEMT * 4 + hx) * 256 + 4 * lane;
#pragma unroll 8
    for (int kk = 0; kk < 32; ++kk) { const int key = w * 32 + kk; const f32x4 kv = *(const f32x4*)(Kc + (size_t)key * 1024);
        float s = (q4[0] * kv[0] + q4[1] * kv[1]) + (q4[2] * kv[2] + q4[3] * kv[3]); s = wave_sum(s);
        if (lane == 0) scs[key] = s; }
    __syncthreads();
    const f32x4 s4 = *(LAS const f32x4*)(scs + 4 * lane);
    float mx = fmaxf(fmaxf(s4[0], s4[1]), fmaxf(s4[2], s4[3]));
#pragma unroll
    for (int o = 1; o < 64; o <<= 1) mx = fmaxf(mx, __shfl_xor(mx, o));
    float l = __builtin_amdgcn_exp2f(s4[0] - mx) + __builtin_amdgcn_exp2f(s4[1] - mx) + __builtin_amdgcn_exp2f(s4[2] - mx) + __builtin_amdgcn_exp2f(s4[3] - mx);
    l = wave_sum(l);
    float o4[4] = {0.f, 0.f, 0.f, 0.f};
#pragma unroll 8
    for (int kk = 0; kk < 32; ++kk) { const int key = w * 32 + kk; const float p = __builtin_amdgcn_exp2f(scs[key] - mx); const f32x4 vv = *(const f32x4*)(Vc + (size_t)key * 1024);
        o4[0] += p * vv[0]; o4[1] += p * vv[1]; o4[2] += p * vv[2]; o4[3] += p * vv[3]; }
    *(LAS f32x4*)(part + w * 256 + 4 * lane) = (f32x4){o4[0], o4[1], o4[2], o4[3]};
    __syncthreads();
    if (F.tid < 256) { float s = 0.f;
#pragma unroll
        for (int k = 0; k < 8; ++k) s += part[k * 256 + F.tid];
        F.OX[(size_t)(MP + n) * 1024 + hx * 256 + F.tid] = (bf16)f2bf(s / l); }
    __syncthreads();
}
__device__ __forceinline__ void p6_cross(Frame& F) {
    for (int du = F.vcu; du < 256; du += F.G) {
        const int pair = du >> 3, b = pair >> 2, hx = pair & 3;
        __syncthreads();
        cross_load_v(F, b, hx);
        __syncthreads();
        cross_unit(F, b, hx, 2 * (du & 7));
        cross_unit(F, b, hx, 2 * (du & 7) + 1);
    }
    __syncthreads();
    for (int u = F.vcu; u < NS * 4; u += F.G) cross_sample_unit(F, u >> 2, u & 3);
}
__device__ __forceinline__ void unpack8(const v4u v, float (&f)[8]) { f[0] = bflo(v.x); f[1] = bfhi(v.x); f[2] = bflo(v.y); f[3] = bfhi(v.y); f[4] = bflo(v.z); f[5] = bfhi(v.z); f[6] = bflo(v.w); f[7] = bfhi(v.w); }
__device__ __forceinline__ void ld8f(const float* p, float (&f)[8]) { const f32x4 a = *(const f32x4*)p, b = *(const f32x4*)(p + 4); f[0] = a[0]; f[1] = a[1]; f[2] = a[2]; f[3] = a[3]; f[4] = b[0]; f[5] = b[1]; f[6] = b[2]; f[7] = b[3]; }
__device__ __forceinline__ void p9_conv(Frame& F) {
    const long gtid = (long)F.vcu * (NWAVES * 64) + F.tid, gthreads = (long)F.G * (NWAVES * 64);
    constexpr int CH = DFF / 8;
    for (long i = gtid; i < (long)MT * CH; i += gthreads) {
        const int r = (int)(i / CH), j0 = (int)(i - (long)r * CH) * 8;
        float g0[8], g1[8], g2[8], vl[8], w0[8], w1[8], w2[8], cb[8];
        unpack8(*(const v4u*)(F.GV + (size_t)r * UPN + j0), g2);
        unpack8(*(const v4u*)(F.GV + (size_t)r * UPN + DFF + j0), vl);
        if (r < MP) { const int t = r & (S - 1);
            if (t >= 1) unpack8(*(const v4u*)(F.GV + (size_t)(r - 1) * UPN + j0), g1); else { for (int e = 0; e < 8; ++e) g1[e] = 0.f; }
            if (t >= 2) unpack8(*(const v4u*)(F.GV + (size_t)(r - 2) * UPN + j0), g0); else { for (int e = 0; e < 8; ++e) g0[e] = 0.f; }
        } else { const int n = r - MP; ld8f(F.state_conv + ((size_t)n * 2 + 0) * DFF + j0, g0); ld8f(F.state_conv + ((size_t)n * 2 + 1) * DFF + j0, g1); }
        ld8f(F.conv_w + j0, w0); ld8f(F.conv_w + DFF + j0, w1); ld8f(F.conv_w + 2 * DFF + j0, w2); ld8f(F.conv_b + j0, cb);
        float a[8];
#pragma unroll
        for (int e = 0; e < 8; ++e) { const float c = cb[e] + w0[e] * g0[e] + w1[e] * g1[e] + w2[e] * g2[e]; a[e] = c / (1.0f + __builtin_amdgcn_exp2f(-c * LOG2E)) * vl[e]; }
        v4u o; o.x = pk2(a[0], a[1]); o.y = pk2(a[2], a[3]); o.z = pk2(a[4], a[5]); o.w = pk2(a[6], a[7]);
        *(v4u*)(F.ACT + (size_t)r * DFF + j0) = o;
        float* so = nullptr;
        if (r < MP) { const int t = r & (S - 1), b = r >> 12; if (t >= S - 2) so = F.out + O_PCV + ((size_t)b * 2 + (t - (S - 2))) * DFF + j0; }
        else so = F.out + O_SCV + ((size_t)(r - MP) * 2 + 1) * DFF + j0;
        if (so) { *(f32x4*)so = (f32x4){g2[0], g2[1], g2[2], g2[3]}; *(f32x4*)(so + 4) = (f32x4){g2[4], g2[5], g2[6], g2[7]}; }
    }
}
__device__ __forceinline__ void p11_final(Frame& F) {
    const int gw = F.vcu * NWAVES + F.wave, NGW = F.G * NWAVES, lane = F.lane;
    for (int r = gw; r < MT; r += NGW) {
        float tot = 0.f;
        if (lane < 16) tot = F.SSQ3[(size_t)r * 16 + lane];
        tot = wave_sum(tot);
        const float rstd = 1.0f / sqrtf(tot * (1.0f / D) + EPS);
        const f32x4* xr = (const f32x4*)(F.XRES + (size_t)r * D) + lane; const f32x4* gr = (const f32x4*)F.g_final + lane; f32x4* yr = (f32x4*)(F.out + (size_t)r * D) + lane;
#pragma unroll
        for (int j = 0; j < 4; ++j) { const f32x4 v = xr[64 * j], g = gr[64 * j]; yr[64 * j] = v * rstd * g; }
    }
}

struct Args { const float* in[27]; float* out; unsigned char* ws; int ph_lo, ph_hi; };
__global__ void __launch_bounds__(NWAVES * 64, 2) fwd(Args args) {
    extern __shared__ __attribute__((aligned(16))) unsigned char lds[];
    Frame F;
    F.lds = (LAS unsigned char*)lds;
    F.MISC = (volatile LAS unsigned*)(F.lds + MISC_OFF);
    F.tid = threadIdx.x; F.lane = F.tid & 63; F.wave = __builtin_amdgcn_readfirstlane(F.tid >> 6);
    F.G = gridDim.x; { const int bx = blockIdx.x; F.vcu = (F.G % 8 == 0) ? (bx % 8) * (F.G / 8) + bx / 8 : bx; }
    unsigned char* ws = args.ws;
    F.ctl = (gu32*)(ws + WS_CTL);
    F.x_prompt = args.in[0]; F.x_sample = args.in[1]; F.cache_a_k = args.in[2]; F.cache_a_v = args.in[3]; F.cache_b_k = args.in[4]; F.cache_b_v = args.in[5];
    F.cache_mem_k = args.in[6]; F.cache_mem_v = args.in[7]; F.state_conv = args.in[8]; F.mem_prompt = args.in[9]; F.g_mix = args.in[10]; F.w_in = args.in[11];
    F.g_out_a = args.in[12]; F.g_out_b = args.in[13]; F.sinks = args.in[14]; F.w_out = args.in[15]; F.g_cross = args.in[16]; F.g_mem = args.in[17]; F.w_xq = args.in[18];
    F.w_mem_kv = args.in[19]; F.w_xo = args.in[20]; F.g_ffn = args.in[21]; F.w_up = args.in[22]; F.conv_w = args.in[23]; F.conv_b = args.in[24]; F.w_down = args.in[25]; F.g_final = args.in[26];
    F.out = args.out;
    F.WIN = (bf16*)(ws + WS_WIN); F.WOUT = (bf16*)(ws + WS_WOUT); F.WXQ = (bf16*)(ws + WS_WXQ); F.WMKV = (bf16*)(ws + WS_WMKV); F.WXO = (bf16*)(ws + WS_WXO); F.WUP = (bf16*)(ws + WS_WUP); F.WDN = (bf16*)(ws + WS_WDN);
    F.MEMN = (bf16*)(ws + WS_MEMN); F.MK = (bf16*)(ws + WS_MK); F.MV = (bf16*)(ws + WS_MV); F.XN = (bf16*)(ws + WS_XN); F.Z = (bf16*)(ws + WS_Z); F.PO = (bf16*)(ws + WS_PO); F.OB = (bf16*)(ws + WS_OB);
    F.OC = (bf16*)(ws + WS_OC); F.QX = (bf16*)(ws + WS_QX); F.OX = (bf16*)(ws + WS_OX); F.GV = (bf16*)(ws + WS_GV); F.ACT = (bf16*)(ws + WS_ACT);
    F.SSQ1 = (float*)(ws + WS_SSQ1); F.SSQ2 = (float*)(ws + WS_SSQ2); F.SSQ3 = (float*)(ws + WS_SSQ3); F.SO = (float*)(ws + WS_SO); F.PL = (float*)(ws + WS_PL); F.XRES = (float*)(ws + WS_XRES);
    for (int u = F.tid; u < (LDS_BYTES - LDSCTL_OFF) / 4; u += NWAVES * 64) ((LAS unsigned*)(F.lds + LDSCTL_OFF))[u] = 0u;
    __syncthreads();
    XcdBarrier bar; bar.bar = (unsigned*)(F.ctl + CW_BAR); bar.x = 0; bar.st = nullptr;
    if (N_LAUNCHES == 1) bar = xcd_barrier_post((unsigned*)(F.ctl + CW_BAR), F.MISC + 8);
    const int lo = args.ph_lo, hi = args.ph_hi;
#define IN(k) (lo <= (k) && (k) < hi)
#define SEAM(k) do { if (IN(k) && IN((k) + 1)) xcd_barrier(bar); } while (0)
    typedef pg8::bf16_t pb;
    if (IN(0)) { p0_prologue(F); }
    SEAM(0);
    if (IN(1)) {
        { pg8::Gemm g{(const pb*)F.XN, (const pb*)F.WIN, MPAD, ZP, D}; pg8::StaticOrder So; So.init(MPAD, ZP, F.G, (int)blockIdx.x);
          pg8::EpiInProj E{(pb*)F.Z, F.out};
          pg8::gemm_phase<pg8::EpiInProj, pg8::StaticOrder, true, true>(F.lds, g, So, E); }
        { pg8::Gemm g{(const pb*)F.MEMN, (const pb*)F.WMKV, NB * MEMT, 2048, D}; pg8::StaticOrder So; So.init(NB * MEMT, 2048, F.G, (int)((blockIdx.x + F.G - (137 % F.G)) % F.G));
          pg8::EpiMemKV E{(pb*)F.MK, (pb*)F.MV, F.out};
          pg8::gemm_phase<pg8::EpiMemKV, pg8::StaticOrder, true, true>(F.lds, g, So, E); }
    }
    SEAM(1);
    if (IN(2)) { p2_attention(F); }
    SEAM(2);
    if (IN(3)) { p3_mix(F); }
    SEAM(3);
    if (IN(4)) {
        pg8::Gemm g{(const pb*)F.OC, (const pb*)F.WOUT, MPAD, D, D}; pg8::StaticOrder So; So.init(MPAD, D, F.G, (int)blockIdx.x);
        pg8::EpiResid<true> E{F.x_prompt, F.x_sample, F.XRES, (pb*)F.XN, F.SSQ1};
        pg8::gemm_phase<pg8::EpiResid<true>, pg8::StaticOrder, true, true>(F.lds, g, So, E);
    }
    SEAM(4);
    if (IN(5)) {
        pg8::Gemm g{(const pb*)F.XN, (const pb*)F.WXQ, MPAD, D, D}; pg8::StaticOrder So; So.init(MPAD, D, F.G, (int)blockIdx.x);
        pg8::EpiScaleBf16 E{(pb*)F.QX, D, F.SSQ1, QSCALE256};
        pg8::gemm_phase<pg8::EpiScaleBf16, pg8::StaticOrder, true, true>(F.lds, g, So, E);
    }
    SEAM(5);
    if (IN(6)) { p6_cross(F); }
    SEAM(6);
    if (IN(7)) {
        pg8::Gemm g{(const pb*)F.OX, (const pb*)F.WXO, MPAD, D, D}; pg8::StaticOrder So; So.init(MPAD, D, F.G, (int)blockIdx.x);
        pg8::EpiResid<false> E{nullptr, nullptr, F.XRES, (pb*)F.XN, F.SSQ2};
        pg8::gemm_phase<pg8::EpiResid<false>, pg8::StaticOrder, true, true>(F.lds, g, So, E);
    }
    SEAM(7);
    if (IN(8)) {
        pg8::Gemm g{(const pb*)F.XN, (const pb*)F.WUP, MPAD, UPN, D}; pg8::StaticOrder So; So.init(MPAD, UPN, F.G, (int)blockIdx.x);
        pg8::EpiScaleBf16 E{(pb*)F.GV, UPN, F.SSQ2, 1.0f};
        pg8::gemm_phase<pg8::EpiScaleBf16, pg8::StaticOrder, true, true>(F.lds, g, So, E);
    }
    SEAM(8);
    if (IN(9)) { p9_conv(F); }
    SEAM(9);
    if (IN(10)) {
        pg8::Gemm g{(const pb*)F.ACT, (const pb*)F.WDN, MPAD, D, DFF}; pg8::StaticOrder So; So.init(MPAD, D, F.G, (int)blockIdx.x);
        pg8::EpiResid<false> E{nullptr, nullptr, F.XRES, nullptr, F.SSQ3};
        pg8::gemm_phase<pg8::EpiResid<false>, pg8::StaticOrder, true, true>(F.lds, g, So, E);
    }
    SEAM(10);
    if (IN(11)) { p11_final(F); }
#undef IN
#undef SEAM
}

extern "C" void kernel_launch(void* const* d_in, const int* in_sizes, int n_in, void* d_out, int out_size, void* d_ws, size_t ws_size, hipStream_t stream) {
    static int grid = 0;
    if (grid == 0) {
        if (n_in != 27 || (size_t)out_size != O_END || ws_size < WS_END) { fprintf(stderr, "kernel_launch: unexpected shapes: n_in %d out %d ws %zu\n", n_in, out_size, ws_size); grid = -1; return; }
        int dev = 0, cus = 0, per_cu = 0;
        if (hipGetDevice(&dev) != hipSuccess || hipDeviceGetAttribute(&cus, hipDeviceAttributeMultiprocessorCount, dev) != hipSuccess) { grid = -1; return; }
        if (hipFuncSetAttribute((const void*)fwd, hipFuncAttributeMaxDynamicSharedMemorySize, LDS_BYTES) != hipSuccess) { fprintf(stderr, "kernel_launch: hipFuncSetAttribute failed\n"); grid = -1; return; }
        if (hipOccupancyMaxActiveBlocksPerMultiprocessor(&per_cu, (const void*)fwd, NWAVES * 64, LDS_BYTES) != hipSuccess || per_cu < 1) fprintf(stderr, "kernel_launch: occupancy query reports %d\n", per_cu);
        (void)hipGetLastError();
        grid = cus;
    }
    if (grid < 0) return;
    (void)hipMemsetAsync((char*)d_ws + WS_CTL, 0, CTL_ZERO_BYTES, stream);
    Args a{};
    for (int i = 0; i < 27; ++i) a.in[i] = (const float*)d_in[i];
    a.out = (float*)d_out; a.ws = (unsigned char*)d_ws;
    if (N_LAUNCHES == 1) { a.ph_lo = 0; a.ph_hi = NPH; hipLaunchKernelGGL(fwd, dim3(grid), dim3(NWAVES * 64), LDS_BYTES, stream, a); }
    else for (int p = 0; p < NPH; ++p) { a.ph_lo = p; a.ph_hi = p + 1; hipLaunchKernelGGL(fwd, dim3(grid), dim3(NWAVES * 64), LDS_BYTES, stream, a); }
}
```

```cpp
#include <hip/hip_runtime.h>
#include <cstdio>
#include <cstdint>
namespace pg8 {
#define PG8_LAS __attribute__((address_space(3)))
typedef unsigned short bf16_t;
typedef short bf16x8 __attribute__((ext_vector_type(8)));
typedef float f32x4 __attribute__((ext_vector_type(4)));
typedef unsigned u32x4 __attribute__((ext_vector_type(4)));
constexpr int BM = 256, BK = 64, HALF = 128, HTB = HALF * BK * 2  , STAGE_BYTES = 8 * HTB, NXCD = 8, WGM = 8;

__host__ __device__ __forceinline__ int lds_byte(int r, int c) { const int st = (r >> 4) * 2 + (c >> 5), rr = r & 15, cc = c & 31, ob = rr * 64 + cc * 2; return st * 1024 + (ob ^ (((ob >> 9) & 1) << 5)); }
__host__ __device__ __forceinline__ void stage_rc(int b, int& R, int& C) { const int st = b / 1024, sb = b % 1024, swz = sb ^ (((sb >> 9) & 1) << 5); R = (st >> 1) * 16 + swz / 64; C = (st & 1) * 32 + (swz % 64) / 2; }
__host__ __device__ __forceinline__ int perm32(int rho) { const int n = rho >> 4, i = rho & 15; return 8 * (i >> 2) + 4 * n + (i & 3); }

struct Unit { int pm, pn; };
struct Gemm { const bf16_t* A; const bf16_t* Bt; int M, N, K; };

struct StaticOrder {
    int nM, nN, nwg, G, c;
    __host__ __device__ void init(int M, int N, int G_, int c_) { nM = M / BM; nN = N / BM; nwg = nM * nN; G = G_; c = c_; }
    __host__ __device__ bool next(int i, Unit& u) const {
        const long L = (long)i * G + c; if (L >= nwg) return false;
        int wgid = (int)L; { const int q = nwg / NXCD, r = nwg % NXCD, xcd = wgid % NXCD, off = wgid / NXCD; wgid = (xcd < r ? xcd * (q + 1) : r * (q + 1) + (xcd - r) * q) + off; }
        const int nig = WGM * nN, gid = wgid / nig, fm = gid * WGM, gsz = (nM - fm) < WGM ? (nM - fm) : WGM;
        u.pm = fm + ((wgid % nig) % gsz); u.pn = (wgid % nig) / gsz; return true;
    }
    __device__ __forceinline__ void a_ready(const Unit&) const {}
    __device__ __forceinline__ void done(const Unit&) const {}
};

__device__ __forceinline__ unsigned cvt_pk_bf16(float lo, float hi) { unsigned r; asm volatile("v_cvt_pk_bf16_f32 %0, %1, %2" : "=v"(r) : "v"(lo), "v"(hi)); return r; }
typedef float f32x2 __attribute__((ext_vector_type(2)));
typedef unsigned u32x2 __attribute__((ext_vector_type(2)));
namespace shp {
constexpr int D = 1024, NB = 8, S = 4096, MP = NB * S, NS = 128, MT = MP + NS, MPAD = 33024;
constexpr int ZP = 2304, DFF = 2816, UPN = 5632, LA = 2048, LB = 128, MEMT = 256;
constexpr float LOG2E = 1.4426950408889634f;
constexpr float QSCALE64 = 0.125f * LOG2E, QSCALE256 = 0.0625f * LOG2E, EPS = 1e-6f;
constexpr size_t O_YP = 0;
constexpr size_t O_YS = O_YP + (size_t)MP * D;
constexpr size_t O_PAK = O_YS + (size_t)NS * D;
constexpr size_t O_PAV = O_PAK + (size_t)NB * LA * 512;
constexpr size_t O_PBK = O_PAV + (size_t)NB * LA * 512;
constexpr size_t O_PBV = O_PBK + (size_t)NB * LB * 128;
constexpr size_t O_PMK = O_PBV + (size_t)NB * LB * 128;
constexpr size_t O_PMV = O_PMK + (size_t)NB * MEMT * 1024;
constexpr size_t O_PCV = O_PMV + (size_t)NB * MEMT * 1024;
constexpr size_t O_SAK = O_PCV + (size_t)NB * 2 * DFF;
constexpr size_t O_SAV = O_SAK + (size_t)NS * LA * 512;
constexpr size_t O_SBK = O_SAV + (size_t)NS * LA * 512;
constexpr size_t O_SBV = O_SBK + (size_t)NS * LB * 128;
constexpr size_t O_SCV = O_SBV + (size_t)NS * LB * 128;
constexpr size_t O_END = O_SCV + (size_t)NS * 2 * DFF;
}
struct EpiInProj {
    static constexpr bool PERM = true, AFTER_DRAIN = false;
    bf16_t* Z; float* out;
    __device__ __forceinline__ void operator()(const f32x4 (&acc)[2][2][4][2], const Unit& u, int wr, int wc, int fr, int fq) const {
        using namespace shp;
        const int ct = u.pn * BM;
        int fqo = fq; asm volatile("" : "+v"(fqo));
        const int d0 = 16 * (wc & 1) + 4 * fqo;
        float inv[4];
#pragma unroll
        for (int i = 0; i < 4; ++i) inv[i] = __builtin_amdgcn_exp2f(-(float)(d0 + i) * (13.287712379549449f / 32.0f)) * 0.15915494309189535f;
#pragma unroll
        for (int ai = 0; ai < 2; ++ai)
#pragma unroll
            for (int m = 0; m < 4; ++m) {
                const int r = u.pm * BM + ai * HALF + wr * 64 + m * 16 + fr;
                const bool prompt = r < MP, sample = (r >= MP) && (r < MT);
                const int t = r & (S - 1), b = r >> 12, n = r - MP;
                const float pos = prompt ? (float)t : 16384.0f;
                float cs[4], sn[4];
#pragma unroll
                for (int i = 0; i < 4; ++i) { float rev = pos * inv[i]; rev -= __builtin_floorf(rev); cs[i] = __builtin_amdgcn_cosf(rev); sn[i] = __builtin_amdgcn_sinf(rev); }
                bf16_t* zrow = Z + (size_t)r * ZP;
#pragma unroll
                for (int bj = 0; bj < 2; ++bj) {
                    const int cb = ct + bj * HALF + wc * 32 + 8 * fq;
                    const int hb = cb & ~63;
                    const f32x4 a0 = acc[ai][bj][m][0], a1 = acc[ai][bj][m][1];
                    const bool is_v = (ct == 1024) || (ct == 1280) || (ct == 2048 && bj == 1);
                    if (is_v) {
                        u32x4 w; w.x = cvt_pk_bf16(a0[0], a0[1]); w.y = cvt_pk_bf16(a0[2], a0[3]); w.z = cvt_pk_bf16(a1[0], a1[1]); w.w = cvt_pk_bf16(a1[2], a1[3]);
                        *(u32x4*)(zrow + cb) = w;
                        float* so = nullptr;
                        if (ct < 2048) { const int c = cb - 1024;
                            if (prompt && t >= S - LA) so = out + O_PAV + ((size_t)b * LA + (t - (S - LA))) * 512 + c;
                            else if (sample) so = out + O_SAV + ((size_t)n * LA + (LA - 1)) * 512 + c;
                        } else { const int c = cb - 2176;
                            if (prompt && t >= S - LB) so = out + O_PBV + ((size_t)b * LB + (t - (S - LB))) * 128 + c;
                            else if (sample) so = out + O_SBV + ((size_t)n * LB + (LB - 1)) * 128 + c;
                        }
                        if (so) { __builtin_nontemporal_store(a0, (f32x4*)so); __builtin_nontemporal_store(a1, (f32x4*)(so + 4)); }
                    } else {
                        const bool is_q = (ct < 512) || (ct >= 1536 && ct < 2048);
                        const float x1[4] = {a0[0], a0[2], a1[0], a1[2]}, x2[4] = {a0[1], a0[3], a1[1], a1[3]};
                        float o1[4], o2[4];
#pragma unroll
                        for (int i = 0; i < 4; ++i) { o1[i] = x1[i] * cs[i] - x2[i] * sn[i]; o2[i] = x2[i] * cs[i] + x1[i] * sn[i]; }
                        if (is_q) {
#pragma unroll
                            for (int i = 0; i < 4; ++i) { o1[i] *= QSCALE64; o2[i] *= QSCALE64; }
                        }
                        u32x2 lo, hi; lo.x = cvt_pk_bf16(o1[0], o1[1]); lo.y = cvt_pk_bf16(o1[2], o1[3]); hi.x = cvt_pk_bf16(o2[0], o2[1]); hi.y = cvt_pk_bf16(o2[2], o2[3]);
                        *(u32x2*)(zrow + hb + d0) = lo; *(u32x2*)(zrow + hb + 32 + d0) = hi;
                        if (!is_q) {
                            float* so = nullptr;
                            if (ct < 2048) { const int c = hb - 512 + d0;
                                if (prompt && t >= S - LA) so = out + O_PAK + ((size_t)b * LA + (t - (S - LA))) * 512 + c;
                                else if (sample) so = out + O_SAK + ((size_t)n * LA + (LA - 1)) * 512 + c;
                            } else { const int c = hb - 2048 + d0;
                                if (prompt && t >= S - LB) so = out + O_PBK + ((size_t)b * LB + (t - (S - LB))) * 128 + c;
                                else if (sample) so = out + O_SBK + ((size_t)n * LB + (LB - 1)) * 128 + c;
                            }
                            if (so) { __builtin_nontemporal_store((f32x4){o1[0], o1[1], o1[2], o1[3]}, (f32x4*)so); __builtin_nontemporal_store((f32x4){o2[0], o2[1], o2[2], o2[3]}, (f32x4*)(so + 32)); }
                        }
                    }
                }
            }
    }
};
struct EpiMemKV {
    static constexpr bool PERM = true, AFTER_DRAIN = false;
    bf16_t* MK; bf16_t* MV; float* out;
    __device__ __forceinline__ void operator()(const f32x4 (&acc)[2][2][4][2], const Unit& u, int wr, int wc, int fr, int fq) const {
        using namespace shp;
        const bool isv = u.pn >= 4; const int ct = (u.pn & 3) * BM;
        bf16_t* B = isv ? MV : MK; float* O = out + (isv ? O_PMV : O_PMK);
#pragma unroll
        for (int ai = 0; ai < 2; ++ai)
#pragma unroll
            for (int m = 0; m < 4; ++m) { const size_t r = (size_t)(u.pm * BM + ai * HALF + wr * 64 + m * 16 + fr);
#pragma unroll
                for (int bj = 0; bj < 2; ++bj) { const int c = ct + bj * HALF + wc * 32 + 8 * fq; const f32x4 a0 = acc[ai][bj][m][0], a1 = acc[ai][bj][m][1];
                    u32x4 w; w.x = cvt_pk_bf16(a0[0], a0[1]); w.y = cvt_pk_bf16(a0[2], a0[3]); w.z = cvt_pk_bf16(a1[0], a1[1]); w.w = cvt_pk_bf16(a1[2], a1[3]);
                    *(u32x4*)(B + r * 1024 + c) = w; __builtin_nontemporal_store(a0, (f32x4*)(O + r * 1024 + c)); __builtin_nontemporal_store(a1, (f32x4*)(O + r * 1024 + c + 4)); } }
    }
};
template <bool FIRST> struct EpiResid {
    static constexpr bool PERM = false, AFTER_DRAIN = false;
    const float* xp;
    bf16_t* xb; float* ssq;
    __device__ __forceinline__ void operator()(const f32x4 (&acc)[2][2][4][2], const Unit& u, int wr, int wc, int fr, int fq) const {
        using namespace shp;
#pragma unroll
        for (int ai = 0; ai < 2; ++ai)
#pragma unroll
            for (int m = 0; m < 4; ++m) { const size_t r = (size_t)(u.pm * BM + ai * HALF + wr * 64 + m * 16 + fr);
                float q = 0.f;
#pragma unroll
                for (int bj = 0; bj < 2; ++bj)
#pragma unroll
                    for (int n = 0; n < 2; ++n) { const int c = u.pn * BM + bj * HALF + wc * 32 + n * 16 + 4 * fq;
                        f32x4 v = acc[ai][bj][m][n];
                        if (FIRST) v = v + __builtin_nontemporal_load((const f32x4*)(xp + r * D + c));
                        else { const u32x2 x = *(const u32x2*)(xb + r * D + c); v[0] += __builtin_bit_cast(float, x.x << 16); v[1] += __builtin_bit_cast(float, x.x & 0xffff0000u); v[2] += __builtin_bit_cast(float, x.y << 16); v[3] += __builtin_bit_cast(float, x.y & 0xffff0000u); }
                        q += (v[0] * v[0] + v[1] * v[1]) + (v[2] * v[2] + v[3] * v[3]);
                        u32x2 w; w.x = cvt_pk_bf16(v[0], v[1]); w.y = cvt_pk_bf16(v[2], v[3]); *(u32x2*)(xb + r * D + c) = w; }
                q += __shfl_xor(q, 16); q += __shfl_xor(q, 32);
                if (fq == 0) ssq[r * 16 + u.pn * 4 + wc] = q; }
    }
};
struct EpiScaleBf16 {
    static constexpr bool PERM = true, AFTER_DRAIN = false;
    bf16_t* O; int ldc; const float* ssq; float scale;
    __device__ __forceinline__ void operator()(const f32x4 (&acc)[2][2][4][2], const Unit& u, int wr, int wc, int fr, int fq) const {
        using namespace shp;
#pragma unroll
        for (int ai = 0; ai < 2; ++ai)
#pragma unroll
            for (int m = 0; m < 4; ++m) { const size_t r = (size_t)(u.pm * BM + ai * HALF + wr * 64 + m * 16 + fr);
                const f32x4 s0 = *(const f32x4*)(ssq + r * 16), s1 = *(const f32x4*)(ssq + r * 16 + 4), s2 = *(const f32x4*)(ssq + r * 16 + 8), s3 = *(const f32x4*)(ssq + r * 16 + 12);
                const f32x4 st = (s0 + s1) + (s2 + s3); const float tot = (st[0] + st[1]) + (st[2] + st[3]);
                const float sc = __builtin_amdgcn_rsqf(tot * (1.0f / D) + EPS) * scale;
#pragma unroll
                for (int bj = 0; bj < 2; ++bj) { const int c = u.pn * BM + bj * HALF + wc * 32 + 8 * fq; const f32x4 a0 = acc[ai][bj][m][0] * sc, a1 = acc[ai][bj][m][1] * sc;
                    u32x4 w; w.x = cvt_pk_bf16(a0[0], a0[1]); w.y = cvt_pk_bf16(a0[2], a0[3]); w.z = cvt_pk_bf16(a1[0], a1[1]); w.w = cvt_pk_bf16(a1[2], a1[3]);
                    *(u32x4*)(O + r * ldc + c) = w; } }
    }
};

template <int CTRL> __device__ __forceinline__ float dpp_mov(float old, float src) {
    return __builtin_bit_cast(float, __builtin_amdgcn_update_dpp(__builtin_bit_cast(int, old), __builtin_bit_cast(int, src), CTRL, 0xf, 0xf, false));
}
struct EpiConvFfn {
    static constexpr bool PERM = true, AFTER_DRAIN = false;
    bf16_t* ACT; const float* ssq; const float* cw; const float* cb; float* out; float* halo; PG8_LAS float* ex;
    __device__ __forceinline__ float row_rstd(size_t r) const {
        using namespace shp;
        const f32x4 s0 = *(const f32x4*)(ssq + r * 16), s1 = *(const f32x4*)(ssq + r * 16 + 4), s2 = *(const f32x4*)(ssq + r * 16 + 8), s3 = *(const f32x4*)(ssq + r * 16 + 12);
        const f32x4 st = (s0 + s1) + (s2 + s3); return __builtin_amdgcn_rsqf(((st[0] + st[1]) + (st[2] + st[3])) * (1.0f / D) + EPS);
    }
    __device__ __forceinline__ void operator()(const f32x4 (&acc)[2][2][4][2], const Unit& u, int wr, int wc, int fr_in, int fq_in) const {
        using namespace shp;
        int fr = fr_in, fq = fq_in; asm volatile("" : "+v"(fr), "+v"(fq));
        const int j0 = u.pn * 128 + wc * 32 + 8 * fq;
        PG8_LAS float* rsb = ex + 1024;
        { int tid_ = (int)threadIdx.x; asm volatile("" : "+v"(tid_));
          if (tid_ < 256) rsb[tid_] = row_rstd((size_t)(u.pm * BM + tid_)); }
        asm volatile("s_waitcnt lgkmcnt(0)" ::: "memory"); __builtin_amdgcn_s_barrier(); asm volatile("" ::: "memory");
#pragma unroll
        for (int ai = 0; ai < 2; ++ai) { const float sc = rsb[ai * HALF + wr * 64 + 48 + fr];
            if (fr >= 14) { PG8_LAS float* e = ex + ((((ai * 2 + wr) * 4 + wc) * 2 + (fr - 14)) * 4 + fq) * 8;
                *(PG8_LAS f32x4*)e = acc[ai][0][3][0] * sc; *(PG8_LAS f32x4*)(e + 4) = acc[ai][0][3][1] * sc; } }
        asm volatile("s_waitcnt lgkmcnt(0)" ::: "memory"); __builtin_amdgcn_s_barrier(); asm volatile("" ::: "memory");
        float w0[8], w1[8], w2[8], cbv[8];
        { const f32x4 a0 = *(const f32x4*)(cw + j0), a1 = *(const f32x4*)(cw + j0 + 4), b0 = *(const f32x4*)(cw + DFF + j0), b1 = *(const f32x4*)(cw + DFF + j0 + 4),
                      c0 = *(const f32x4*)(cw + 2 * DFF + j0), c1 = *(const f32x4*)(cw + 2 * DFF + j0 + 4), d0 = *(const f32x4*)(cb + j0), d1 = *(const f32x4*)(cb + j0 + 4);
#pragma unroll
          for (int i = 0; i < 4; ++i) { w0[i] = a0[i]; w0[4 + i] = a1[i]; w1[i] = b0[i]; w1[4 + i] = b1[i]; w2[i] = c0[i]; w2[4 + i] = c1[i]; cbv[i] = d0[i]; cbv[4 + i] = d1[i]; } }
        const bool first_panel = (u.pm & 15) == 0;
#pragma unroll
        for (int ai = 0; ai < 2; ++ai) {
            float prev[8];
#pragma unroll
            for (int i = 0; i < 8; ++i) prev[i] = 0.f;
            const bool has_pred = (wr == 1) || (ai == 1);
            if (has_pred && fr >= 14) { const int pa = (wr == 1) ? ai : 0, pw = (wr == 1) ? 0 : 1;
                const PG8_LAS float* ep = ex + ((((pa * 2 + pw) * 4 + wc) * 2 + (fr - 14)) * 4 + fq) * 8;
                const f32x4 e0 = *(const PG8_LAS f32x4*)ep, e1 = *(const PG8_LAS f32x4*)(ep + 4);
#pragma unroll
                for (int i = 0; i < 4; ++i) { prev[i] = e0[i]; prev[4 + i] = e1[i]; } }
#pragma unroll
            for (int m = 0; m < 4; ++m) {
                const int ur = ai * HALF + wr * 64 + m * 16 + fr; const size_t r = (size_t)u.pm * BM + ur;
                const float sc = rsb[ur];
                float x[8], vv[8], a[8];
#pragma unroll
                for (int i = 0; i < 4; ++i) { x[i] = acc[ai][0][m][0][i] * sc; x[4 + i] = acc[ai][0][m][1][i] * sc; vv[i] = acc[ai][1][m][0][i] * sc; vv[4 + i] = acc[ai][1][m][1][i] * sc; }
#pragma unroll
                for (int i = 0; i < 8; ++i) {
                    const float p1 = dpp_mov<0x111>(dpp_mov<0x121>(prev[i], prev[i]), x[i]), p2 = dpp_mov<0x112>(dpp_mov<0x122>(prev[i], prev[i]), x[i]);
                    const float c = cbv[i] + w0[i] * p2 + w1[i] * p1 + w2[i] * x[i];
                    a[i] = c * __builtin_amdgcn_rcpf(1.0f + __builtin_amdgcn_exp2f(-c * LOG2E)) * vv[i]; }
                const bool halo_row = (!first_panel) && (ur < 2);
                if (!halo_row) { u32x4 w; w.x = cvt_pk_bf16(a[0], a[1]); w.y = cvt_pk_bf16(a[2], a[3]); w.z = cvt_pk_bf16(a[4], a[5]); w.w = cvt_pk_bf16(a[6], a[7]); *(u32x4*)(ACT + r * DFF + j0) = w; }
                else { float* hg = halo + ((size_t)(128 + u.pm) * 2 + ur) * DFF + j0; float* hv = halo + ((size_t)(256 + u.pm) * 2 + ur) * DFF + j0;
                    *(f32x4*)hg = (f32x4){x[0], x[1], x[2], x[3]}; *(f32x4*)(hg + 4) = (f32x4){x[4], x[5], x[6], x[7]};
                    *(f32x4*)hv = (f32x4){vv[0], vv[1], vv[2], vv[3]}; *(f32x4*)(hv + 4) = (f32x4){vv[4], vv[5], vv[6], vv[7]}; }
                if (ur >= 254) { float* hl = halo + ((size_t)u.pm * 2 + (ur - 254)) * DFF + j0;
                    *(f32x4*)hl = (f32x4){x[0], x[1], x[2], x[3]}; *(f32x4*)(hl + 4) = (f32x4){x[4], x[5], x[6], x[7]};
                    if ((u.pm & 15) == 15) { float* pc = out + O_PCV + ((size_t)(u.pm >> 4) * 2 + (ur - 254)) * DFF + j0;
                        *(f32x4*)pc = (f32x4){x[0], x[1], x[2], x[3]}; *(f32x4*)(pc + 4) = (f32x4){x[4], x[5], x[6], x[7]}; } }
#pragma unroll
                for (int i = 0; i < 8; ++i) prev[i] = x[i];
                asm volatile("" ::: "memory");
            }
        }
    }
};
struct NoCopy { static constexpr bool ON = false, X2 = false; unsigned ldsoff; __device__ __forceinline__ void addr(int, const char*&, char*&) const {} __device__ __forceinline__ void xaddr(int, const char*&, char*&) const {} };
template <bool X2_> struct KCopyT {
    static constexpr bool ON = true, X2 = X2_;
    const char* src0; const char* src1; char* dst0; char* dst1; int j0, quota, gw, ngw; unsigned ldsoff; int xj0, xquota;
    __device__ __forceinline__ void xaddr(int j, const char*& s, char*& d) const { const int jj = j < xquota ? j : xquota - 1; addr_id((unsigned)(xj0 + jj) * (unsigned)ngw + (unsigned)gw, s, d); }
    __device__ __forceinline__ void addr(int j, const char*& s, char*& d) const { const int jj = j < quota ? j : quota - 1; addr_id((unsigned)(j0 + jj) * (unsigned)ngw + (unsigned)gw, s, d); }
    __device__ __forceinline__ void addr_id(unsigned cid_in, const char*& s, char*& d) const {
        const unsigned cid = cid_in < 1048064u ? cid_in : 1048063u;
        const bool t1 = cid >= 524032u; const unsigned rem = t1 ? cid - 524032u : cid, n = rem / 4094u, off = rem - n * 4094u;
        const size_t so = (size_t)n * 4194304u + 2048u + (size_t)off * 1024u, dof = (size_t)n * 4194304u + (size_t)off * 1024u;
        s = (t1 ? src1 : src0) + so; d = (t1 ? dst1 : dst0) + dof;
    }
};
typedef KCopyT<false> KCopy; typedef KCopyT<true> KCopy2;
template <class Epi, class Sched, bool ALIGN_EPI = false, bool SP2 = false, class Cp = NoCopy>
__device__ __forceinline__ void gemm_phase(PG8_LAS unsigned char* lds, const Gemm g, const Sched& S, const Epi& E, const Cp C = Cp()) {
    static_assert(!Cp::ON || SP2, "the copy rider is written for the SP2 loop");
    int cl = 0;
#define PG8_CLOAD(slot) do { if constexpr (Cp::ON) { const char* s_; char* d_; C.addr(cl, s_, d_); __builtin_amdgcn_global_load_lds((const unsigned*)(s_ + lane * 16), (PG8_LAS unsigned*)(lds + C.ldsoff + wid * 2048 + (slot) * 1024), 16, 0, 2); ++cl; } } while (0)
#define PG8_CREAD(slot, v_) do { if constexpr (Cp::ON) { v_ = *(const PG8_LAS u32x4*)(lds + C.ldsoff + wid * 2048 + (slot) * 1024 + lane * 16); } } while (0)
#define PG8_CSTORE(idx, v_) do { if constexpr (Cp::ON) { const char* s_; char* d_; C.addr((idx), s_, d_); const int o_ = lane * 16; asm volatile("global_store_dwordx4 %0, %1, %2 nt\n\ts_nop 1" :: "v"(o_), "v"(v_), "s"(d_) : "memory"); } } while (0)
#define PG8_WAIT_VC(nx2) do { if constexpr (Cp::X2) { PG8_WAIT_V(nx2); } else if constexpr (Cp::ON) { PG8_WAIT_V(10); } else { PG8_WAIT_V(8); } } while (0)
#define PG8_CLOAD2() do { if constexpr (Cp::X2) { const char* s_; char* d_; C.xaddr(cx, s_, d_); __builtin_amdgcn_global_load_lds((const unsigned*)(s_ + lane * 16), (PG8_LAS unsigned*)(lds + C.ldsoff + 16384 + wid * 1024), 16, 0, 2); ++cx; } } while (0)
#define PG8_CSTORE2(v_) do { if constexpr (Cp::X2) { const char* s_; char* d_; C.xaddr(cx - 1, s_, d_); const int o_ = lane * 16; asm volatile("global_store_dwordx4 %0, %1, %2 nt\n\ts_nop 1" :: "v"(o_), "v"(v_), "s"(d_) : "memory"); } } while (0)
#define PG8_CREAD2(v_) do { if constexpr (Cp::X2) { v_ = *(const PG8_LAS u32x4*)(lds + C.ldsoff + 16384 + wid * 1024 + lane * 16); } } while (0)
    int cx = 0;
    u32x4 cv = (u32x4){0u, 0u, 0u, 0u};
    const int tid = threadIdx.x, wid = __builtin_amdgcn_readfirstlane(tid >> 6), lane = tid & 63, wr = wid >> 2, wc = wid & 3, fr = lane & 15, fq = lane >> 4;
    const int K = g.K, nt = K / BK;
    unsigned voffA[2], voffB[2];
#pragma unroll
    for (int i = 0; i < 2; ++i) { int R, C; stage_rc(tid * 16 + i * 8192, R, C); const int Rb = Epi::PERM ? ((R & ~31) + perm32(R & 31)) : R;
        voffA[i] = (unsigned)(R * K + C) * 2u; voffB[i] = (unsigned)(Rb * K + C) * 2u; }
    const size_t kstep = (size_t)(BK * 2);
    const size_t hstep = (size_t)HALF * K * 2;
    const size_t tstep = 2 * hstep;
    const unsigned ldsw = (unsigned)wid * 1024u;
    const int aoff = lds_byte(wr * 64 + fr, fq * 8), boff = lds_byte(wc * 32 + fr, fq * 8);
#define PG8_SA(b, h) (((b) * 2 + (h)) * HTB)
#define PG8_SB(b, h) ((4 + (b) * 2 + (h)) * HTB)
#define PG8_STAGE(bufoff, gbase, voff) do { _Pragma("unroll") for (int _i = 0; _i < 2; ++_i) \
        __builtin_amdgcn_global_load_lds((const unsigned*)((const char*)(gbase) + (voff)[_i]), (PG8_LAS unsigned*)(lds + (bufoff) + ldsw + _i * 8192), 16, 0, 0); } while (0)
#define PG8_LDA(dst, b, h) do { _Pragma("unroll") for (int m = 0; m < 4; ++m) _Pragma("unroll") for (int k = 0; k < 2; ++k) dst[m][k] = *(const PG8_LAS bf16x8*)(lds + PG8_SA(b, h) + aoff + m * 2048 + k * 1024); } while (0)
#define PG8_LDB(dst, b, h) do { _Pragma("unroll") for (int n = 0; n < 2; ++n) _Pragma("unroll") for (int k = 0; k < 2; ++k) dst[n][k] = *(const PG8_LAS bf16x8*)(lds + PG8_SB(b, h) + boff + n * 2048 + k * 1024); } while (0)
#define PG8_MMA(ai, bj, At, Bt) do { __builtin_amdgcn_s_setprio(1); _Pragma("unroll") for (int m = 0; m < 4; ++m) _Pragma("unroll") for (int n = 0; n < 2; ++n) _Pragma("unroll") for (int k = 0; k < 2; ++k) \
        acc[ai][bj][m][n] = __builtin_amdgcn_mfma_f32_16x16x32_bf16(Bt[n][k], At[m][k], acc[ai][bj][m][n], 0, 0, 0); __builtin_amdgcn_s_setprio(0); } while (0)
#define PG8_WAIT_V(n) asm volatile("s_waitcnt vmcnt(" #n ")" ::: "memory")
#define PG8_WAIT_L(n) asm volatile("s_waitcnt lgkmcnt(" #n ")" ::: "memory")
#define PG8_BAR __builtin_amdgcn_s_barrier()
#define PG8_SCHED __builtin_amdgcn_sched_barrier(0)
    Unit cur, nxt; int ui = 0;
    if (!S.next(0, cur)) return;
    f32x4 acc[2][2][4][2];
#pragma unroll
    for (int a = 0; a < 2; ++a)
#pragma unroll
        for (int b = 0; b < 2; ++b)
#pragma unroll
            for (int m = 0; m < 4; ++m)
#pragma unroll
                for (int n = 0; n < 2; ++n) acc[a][b][m][n] = (f32x4){0.f, 0.f, 0.f, 0.f};
    bf16x8 At[4][2], B0[2][2], B1[2][2];
    const char* cA = (const char*)g.A + (size_t)cur.pm * tstep; const char* cB = (const char*)g.Bt + (size_t)cur.pn * tstep;
    S.a_ready(cur);
    if constexpr (SP2) {
        PG8_STAGE(PG8_SB(0, 0), cB, voffB); PG8_STAGE(PG8_SB(0, 1), cB + hstep, voffB); PG8_STAGE(PG8_SA(0, 0), cA, voffA); PG8_STAGE(PG8_SA(0, 1), cA + hstep, voffA);
        if (wr == 1) PG8_BAR;
        PG8_WAIT_V(2); PG8_BAR;
        PG8_CLOAD(1);
        PG8_STAGE(PG8_SB(1, 0), cB + kstep, voffB); PG8_STAGE(PG8_SA(1, 0), cA + kstep, voffA); PG8_STAGE(PG8_SB(1, 1), cB + hstep + kstep, voffB);
        PG8_WAIT_V(6); PG8_BAR;
    } else {
        PG8_STAGE(PG8_SB(0, 0), cB, voffB); PG8_STAGE(PG8_SA(0, 0), cA, voffA); PG8_STAGE(PG8_SB(0, 1), cB + hstep, voffB); PG8_STAGE(PG8_SA(0, 1), cA + hstep, voffA);
        if (wr == 1) PG8_BAR;
        PG8_WAIT_V(4); PG8_BAR;
        PG8_STAGE(PG8_SB(1, 0), cB + kstep, voffB); PG8_STAGE(PG8_SA(1, 0), cA + kstep, voffA); PG8_STAGE(PG8_SB(1, 1), cB + hstep + kstep, voffB);
        PG8_WAIT_V(6); PG8_BAR;
    }
    for (;;) {
        const bool has_next = S.next(ui + 1, nxt);
        const char* nA = has_next ? (const char*)g.A + (size_t)nxt.pm * tstep : cA; const char* nB = has_next ? (const char*)g.Bt + (size_t)nxt.pn * tstep : cB;
        for (int t = 0; t < nt; t += 2) {
            const bool last = (t == nt - 2);
            const char* a1 = cA + (size_t)(t + 1) * kstep;
            const char* a2 = last ? nA : cA + (size_t)(t + 2) * kstep; const char* b2 = last ? nB : cB + (size_t)(t + 2) * kstep;
            const char* a3 = a2 + kstep; const char* b3 = b2 + kstep;
            if (last && has_next) S.a_ready(nxt);
            if constexpr (SP2) {
            PG8_LDB(B0, 0, 0); PG8_LDB(B1, 0, 1); PG8_SCHED; PG8_LDA(At, 0, 0); PG8_CLOAD(0); PG8_CLOAD2(); PG8_STAGE(PG8_SA(1, 1), a1 + hstep, voffA);
            PG8_WAIT_VC(12); PG8_WAIT_L(0); PG8_BAR; PG8_MMA(0, 0, At, B0); PG8_MMA(0, 1, At, B1); PG8_BAR; PG8_SCHED;
            PG8_LDA(At, 0, 1); PG8_STAGE(PG8_SB(0, 0), b2, voffB); PG8_STAGE(PG8_SB(0, 1), b2 + hstep, voffB); PG8_STAGE(PG8_SA(0, 0), a2, voffA); PG8_CREAD(1, cv); PG8_CSTORE(cl - 2, cv);
            PG8_WAIT_VC(11); PG8_WAIT_L(0); PG8_BAR; PG8_MMA(1, 0, At, B0); PG8_MMA(1, 1, At, B1); PG8_BAR; PG8_SCHED;
            PG8_LDB(B0, 1, 0); PG8_LDB(B1, 1, 1); PG8_SCHED; PG8_LDA(At, 1, 0); PG8_CLOAD(1); PG8_STAGE(PG8_SA(0, 1), a2 + hstep, voffA);
            PG8_WAIT_VC(10); PG8_WAIT_L(0); PG8_BAR; PG8_MMA(0, 0, At, B0); PG8_MMA(0, 1, At, B1); PG8_BAR; PG8_SCHED;
            PG8_LDA(At, 1, 1); PG8_STAGE(PG8_SB(1, 0), b3, voffB); PG8_STAGE(PG8_SB(1, 1), b3 + hstep, voffB); PG8_STAGE(PG8_SA(1, 0), a3, voffA); PG8_CREAD(0, cv); PG8_CSTORE(cl - 2, cv); PG8_CREAD2(cv); PG8_CSTORE2(cv);
            PG8_WAIT_VC(11); PG8_WAIT_L(0); PG8_BAR; PG8_MMA(1, 0, At, B0); PG8_MMA(1, 1, At, B1); PG8_BAR; PG8_SCHED;
            } else {
            PG8_LDB(B0, 0, 0); PG8_SCHED; PG8_LDA(At, 0, 0); PG8_STAGE(PG8_SA(1, 1), a1 + hstep, voffA);
            PG8_WAIT_L(8); PG8_BAR; PG8_WAIT_L(0); PG8_MMA(0, 0, At, B0); PG8_BAR; PG8_SCHED;
            PG8_LDB(B1, 0, 1); PG8_STAGE(PG8_SB(0, 0), b2, voffB);
            PG8_BAR; PG8_WAIT_L(0); PG8_MMA(0, 1, At, B1); PG8_BAR;
            PG8_LDA(At, 0, 1); PG8_STAGE(PG8_SA(0, 0), a2, voffA);
            PG8_BAR; PG8_WAIT_L(0); PG8_MMA(1, 0, At, B0); PG8_BAR; PG8_SCHED;
            PG8_STAGE(PG8_SB(0, 1), b2 + hstep, voffB);
            PG8_WAIT_V(6); PG8_BAR; PG8_MMA(1, 1, At, B1); PG8_BAR;
            PG8_LDB(B0, 1, 0); PG8_SCHED; PG8_LDA(At, 1, 0); PG8_STAGE(PG8_SA(0, 1), a2 + hstep, voffA);
            PG8_WAIT_L(8); PG8_BAR; PG8_WAIT_L(0); PG8_MMA(0, 0, At, B0); PG8_BAR; PG8_SCHED;
            PG8_LDB(B1, 1, 1); PG8_STAGE(PG8_SB(1, 0), b3, voffB);
            PG8_BAR; PG8_WAIT_L(0); PG8_MMA(0, 1, At, B1); PG8_BAR;
            PG8_LDA(At, 1, 1); PG8_STAGE(PG8_SA(1, 0), a3, voffA);
            PG8_BAR; PG8_WAIT_L(0); PG8_MMA(1, 0, At, B0); PG8_BAR; PG8_SCHED;
            PG8_STAGE(PG8_SB(1, 1), b3 + hstep, voffB);
            PG8_WAIT_V(6); PG8_BAR; PG8_MMA(1, 1, At, B1); PG8_BAR;
            }
        }
        if constexpr (ALIGN_EPI) { if (wr == 0) PG8_BAR; }
        if constexpr (!Epi::AFTER_DRAIN) { E(acc, cur, wr, wc, fr, fq); S.done(cur); }
        if (!has_next) break;
#pragma unroll
        for (int a = 0; a < 2; ++a)
#pragma unroll
            for (int b = 0; b < 2; ++b)
#pragma unroll
                for (int m = 0; m < 4; ++m)
#pragma unroll
                    for (int n = 0; n < 2; ++n) acc[a][b][m][n] = (f32x4){0.f, 0.f, 0.f, 0.f};
        cur = nxt; cA = nA; cB = nB; ++ui;
        if constexpr (ALIGN_EPI) { if (wr == 1) PG8_BAR; }
    }
    PG8_WAIT_V(0);
    if constexpr (!ALIGN_EPI) { if (wr == 0) PG8_BAR; }
    PG8_BAR;
    PG8_CREAD(1, cv); PG8_CSTORE(cl - 1, cv);
    if constexpr (Epi::AFTER_DRAIN) { E.fused(acc, cur, wr, wc, fr, fq, lds, wid, lane); S.done(cur); }
#undef PG8_CLOAD
#undef PG8_CREAD
#undef PG8_CSTORE
#undef PG8_WAIT_VC
#undef PG8_CLOAD2
#undef PG8_CSTORE2
#undef PG8_CREAD2
#undef PG8_SA
#undef PG8_SB
#undef PG8_STAGE
#undef PG8_LDA
#undef PG8_LDB
#undef PG8_MMA
#undef PG8_WAIT_V
#undef PG8_WAIT_L
#undef PG8_BAR
#undef PG8_SCHED
}
}
#define GAS __attribute__((address_space(1)))
#define LAS __attribute__((address_space(3)))
typedef unsigned short bf16;
typedef unsigned v4u __attribute__((ext_vector_type(4)));
typedef float f32x4 __attribute__((ext_vector_type(4)));
typedef short bf16x8 __attribute__((ext_vector_type(8)));
typedef GAS unsigned gu32;
typedef GAS unsigned long long gu64;
#define RLX_AGENT __ATOMIC_RELAXED, __HIP_MEMORY_SCOPE_AGENT
#define LDS_WAIT() asm volatile("s_waitcnt lgkmcnt(0)" ::: "memory")
#define VM_WAIT() asm volatile("s_waitcnt vmcnt(0)" ::: "memory")
__device__ __forceinline__ unsigned long long rt() { return __builtin_amdgcn_s_memrealtime(); }
__device__ __forceinline__ unsigned f2bf(float f) { unsigned u = __builtin_bit_cast(unsigned, f); return (u + 0x7fffu + ((u >> 16) & 1u)) >> 16; }
__device__ __forceinline__ unsigned pk2(float lo, float hi) { return f2bf(lo) | (f2bf(hi) << 16); }

#define XB_TMO      128
#define XB_XCNT(j)  (256  + 64 * (j))
#define XB_XSUB(j)  (1280 + 64 * (j))
#define XB_XGEN(j)  (2304 + 64 * (j))
#define XB_TOP      3328
#define XB_TOPGEN   3392
#define XCD_BAR_WORDS 3456
#define XB_SPIN_CAP (1u << 18)

__device__ __forceinline__ unsigned xb_ld(unsigned* p)              { return __hip_atomic_load(p, __ATOMIC_RELAXED, __HIP_MEMORY_SCOPE_AGENT); }
__device__ __forceinline__ unsigned xb_add(unsigned* p, unsigned v) { return __hip_atomic_fetch_add(p, v, __ATOMIC_RELAXED, __HIP_MEMORY_SCOPE_AGENT); }
__device__ __forceinline__ unsigned xb_xcc_id() { return (unsigned)__builtin_amdgcn_s_getreg((3 << 11) | 20) & 0xFu; }
#define XB_SPIN(cond, bar) do { unsigned _sp = 0; while (cond) { __builtin_amdgcn_s_sleep(1); \
    if ((++_sp & 255u) == 0u) { if (xb_ld(&(bar)[XB_TMO])) break; if (_sp > XB_SPIN_CAP) { atomicAdd(&(bar)[XB_TMO], 1u); break; } } } } while (0)

struct XcdBarrier {
    unsigned* bar; unsigned x;
    volatile LAS unsigned* st;
};

__device__ __forceinline__ XcdBarrier xcd_barrier_post(unsigned* bar, volatile LAS unsigned* st) {
    XcdBarrier b; b.bar = bar; b.x = xb_xcc_id(); b.st = st;
    if (threadIdx.x == 0) (void)xb_add(&bar[XB_XCNT(b.x)], 1u);
    return b;
}
__device__ __forceinline__ void xcd_barrier_complete(unsigned* bar, unsigned x, unsigned& nloc, unsigned& nx) {
    const unsigned G = gridDim.x * gridDim.y * gridDim.z;
    unsigned sum, cnt, mine, sp = 0u;
    for (;;) {
        sum = 0u; cnt = 0u; mine = 0u;
#pragma unroll
        for (unsigned j = 0; j < 16; ++j) { const unsigned c = xb_ld(&bar[XB_XCNT(j)]); sum += c; cnt += (c > 0u) ? 1u : 0u; mine = (j == x) ? c : mine; }
        if (sum == G) break;
        __builtin_amdgcn_s_sleep(1);
        if ((++sp & 255u) == 0u) { if (xb_ld(&bar[XB_TMO])) break; if (sp > XB_SPIN_CAP) { atomicAdd(&bar[XB_TMO], 1u); break; } }
    }
    nloc = mine > 0u ? mine : 1u; nx = cnt > 0u ? cnt : 1u;
}

__device__ __forceinline__ void xcd_barrier(const XcdBarrier& b) {
    asm volatile("s_waitcnt vmcnt(0)" ::: "memory");
    __syncthreads();
    if (threadIdx.x == 0) {
        unsigned* bar = b.bar;
        __builtin_amdgcn_s_waitcnt(0);
        unsigned nloc = b.st[0], nx = b.st[1];
        if (nloc == 0u) { xcd_barrier_complete(bar, b.x, nloc, nx); b.st[0] = nloc; b.st[1] = nx; }
        const unsigned old = xb_add(&bar[XB_XSUB(b.x)], 1u);
        const unsigned gen = old / nloc;
        if (old + 1u == (gen + 1u) * nloc) {
            __builtin_amdgcn_fence(__ATOMIC_RELEASE, "agent");
            asm volatile("s_waitcnt vmcnt(0)" ::: "memory");
            const unsigned og = xb_add(&bar[XB_TOP], 1u);
            const unsigned tg = og / nx;
            if (og + 1u == (tg + 1u) * nx) xb_add(&bar[XB_TOPGEN], 1u);
            else XB_SPIN(xb_ld(&bar[XB_TOPGEN]) == tg, bar);
            __builtin_amdgcn_fence(__ATOMIC_ACQUIRE, "agent");
            xb_add(&bar[XB_XGEN(b.x)], 1u);
            asm volatile("s_waitcnt vmcnt(0)" ::: "memory");
        } else {
            XB_SPIN(xb_ld(&bar[XB_XGEN(b.x)]) == gen, bar);
            __builtin_amdgcn_fence(__ATOMIC_ACQUIRE, "agent");
            asm volatile("s_waitcnt vmcnt(0)" ::: "memory");
        }
    }
    __syncthreads();
}
using namespace pg8::shp;
constexpr int NWAVES = 8;
#ifndef MK_N_LAUNCHES
#define MK_N_LAUNCHES 1
#endif
constexpr int NPH = 12;
constexpr int N_LAUNCHES = MK_N_LAUNCHES;
constexpr size_t MiB = 1u << 20;
constexpr size_t WS_CTL = 0, CTL_ZERO_BYTES = 1 * MiB;
constexpr size_t WS_WIN = 2 * MiB, WS_WOUT = 7 * MiB, WS_WXQ = 9 * MiB, WS_WMKV = 11 * MiB, WS_WXO = 15 * MiB, WS_WUP = 17 * MiB, WS_WDN = 28 * MiB;
constexpr size_t WS_MEMN = 34 * MiB, WS_MK = 38 * MiB, WS_MV = 42 * MiB, WS_SSQ1 = 46 * MiB, WS_SSQ2 = 49 * MiB, WS_SSQ3 = 52 * MiB, WS_SO = 55 * MiB, WS_PL = 56 * MiB;
constexpr size_t WS_XN = 64 * MiB, WS_Z = 130 * MiB, WS_PO = 276 * MiB, WS_OB = 372 * MiB, WS_OC = 404 * MiB, WS_XRES = 470 * MiB, WS_QX = 600 * MiB, WS_OX = 665 * MiB;
constexpr size_t WS_GV = 730 * MiB, WS_ACT = 1085 * MiB, WS_END = 1264 * MiB;
constexpr int CW_BAR = 4096;
constexpr int RING_BYTES = 131072, LDSCTL_OFF = RING_BYTES, MISC_OFF = LDSCTL_OFF + 320, COPY_OFF = RING_BYTES + 1024, EXCH_OFF = COPY_OFF + 16384 + 8192, LDS_BYTES = EXCH_OFF + 4096 + 1024;
constexpr int RIDER_CHUNKS = 468;
constexpr unsigned COPY_CHUNKS = 2u * 524032u;

typedef float f32x16 __attribute__((ext_vector_type(16)));
typedef short s16x4 __attribute__((ext_vector_type(4)));
typedef short v4i16_t __attribute__((ext_vector_type(4)));
typedef unsigned u32x2v __attribute__((ext_vector_type(2)));
constexpr int SWA_NU_HOST = 3 * 2048 + 512;
__device__ __forceinline__ int fresh_tid() { int t = (int)threadIdx.x; asm volatile("" : "+v"(t)); return t; }
#define FTID (fresh_tid())
#define FLANE (fresh_tid() & 63)
__device__ __forceinline__ const float* inptr(int i) {
    const __attribute__((address_space(4))) char* ka = (const __attribute__((address_space(4))) char*)__builtin_amdgcn_kernarg_segment_ptr();
    int off = i * 8; asm volatile("" : "+s"(off));
    return *(const float* const __attribute__((address_space(4)))*)(ka + off);
}
struct Frame {
    LAS unsigned char* lds;
    volatile LAS unsigned* MISC;
    gu32* ctl;
    int wave, vcu, G;
    float* out; unsigned char* ws;
};
__device__ __forceinline__ float wave_sum(float v) {
#pragma unroll
    for (int o = 1; o < 64; o <<= 1) v += __shfl_xor(v, o);
    return v;
}
__device__ __forceinline__ float bf2f(unsigned short h) { return __builtin_bit_cast(float, (unsigned)h << 16); }
__device__ __forceinline__ float bflo(unsigned w) { return __builtin_bit_cast(float, w << 16); }
__device__ __forceinline__ float bfhi(unsigned w) { return __builtin_bit_cast(float, w & 0xffff0000u); }
__device__ __forceinline__ int crow(int r, int hi) { return (r & 3) + 8 * (r >> 2) + 4 * hi; }
__device__ __forceinline__ s16x4 vtr(LAS const unsigned char* p) { return __builtin_bit_cast(s16x4, __builtin_amdgcn_ds_read_tr16_b64_v4i16((LAS v4i16_t*)p)); }
#define VTRA(dst, addr, OFF) asm volatile("ds_read_b64_tr_b16 %0, %1 offset:%c2" : "=&v"(dst) : "v"(addr), "i"(OFF) : "memory")
#define LGKM0() do { asm volatile("s_waitcnt lgkmcnt(0)" ::: "memory"); __builtin_amdgcn_sched_barrier(0); } while (0)
__device__ __forceinline__ unsigned lds_addr(LAS const unsigned char* p) { return (unsigned)(uintptr_t)p; }

constexpr float NEGBIG = -1.0e30f;

__device__ __forceinline__ int drow_of(int n, int mode) {
    if (mode == 1 && (n < 1024 || (n >= 1536 && n < 2176))) { const int dd = n & 63; return (n & ~63) + (dd < 32 ? 2 * dd : 2 * (dd - 32) + 1); }
    if (mode == 2) { const int j = n < DFF ? n : n - DFF; return (j >> 7) * 256 + (n < DFF ? 0 : 128) + (j & 127); }
    return n;
}
__device__ __forceinline__ void p0_transpose_item(const float* W, int K, int N, bf16* WT, const float* ga, const float* gb, int gsplit, int mode, LAS float* scr, int item, int lane) {
    const int nblk = N / 32, kb = item / nblk, nb = item % nblk, k0 = 64 * kb, n0 = 32 * nb;
    float wv_[32];
#pragma unroll
    for (int i = 0; i < 32; ++i) wv_[i] = __builtin_nontemporal_load(W + (size_t)(k0 + 2 * i + (lane >> 5)) * N + n0 + (lane & 31));
#pragma unroll
    for (int i = 0; i < 32; ++i) { const int kk = 2 * i + (lane >> 5); const int k = k0 + kk;
        float g = 1.0f; if (ga) g = (k < gsplit) ? ga[k] : gb[k - gsplit];
        scr[kk * 33 + (lane & 31)] = wv_[i] * g; }
    LDS_WAIT(); asm volatile("" ::: "memory");
    const int c = lane & 7;
#pragma unroll
    for (int j = 0; j < 4; ++j) { const int n = (lane >> 3) + 8 * j; const LAS float* s = scr + (8 * c) * 33 + n;
        v4u o; o.x = pk2(s[0 * 33], s[1 * 33]); o.y = pk2(s[2 * 33], s[3 * 33]); o.z = pk2(s[4 * 33], s[5 * 33]); o.w = pk2(s[6 * 33], s[7 * 33]);
        *(GAS v4u*)(WT + (size_t)drow_of(n0 + n, mode) * K + k0 + 8 * c) = o; }
    LDS_WAIT(); asm volatile("" ::: "memory");
}
__device__ __forceinline__ void rms_rows4_to_bf16(int lane, const float* const (&xrow)[4], bf16* const (&orow)[4]) {
    f32x4 v[4][4];
#pragma unroll
    for (int q = 0; q < 4; ++q)
#pragma unroll
        for (int j = 0; j < 4; ++j) v[q][j] = __builtin_nontemporal_load((const f32x4*)xrow[q] + lane + 64 * j);
#pragma unroll
    for (int q = 0; q < 4; ++q) { float s = 0.f;
#pragma unroll
        for (int j = 0; j < 4; ++j) s += (v[q][j].x * v[q][j].x + v[q][j].y * v[q][j].y) + (v[q][j].z * v[q][j].z + v[q][j].w * v[q][j].w);
        const float rstd = 1.f / sqrtf(wave_sum(s) * (1.f / D) + EPS);
        GAS unsigned long long* o8 = (GAS unsigned long long*)orow[q] + lane;
#pragma unroll
        for (int j = 0; j < 4; ++j) o8[64 * j] = (unsigned long long)pk2(v[q][j].x * rstd, v[q][j].y * rstd) | ((unsigned long long)pk2(v[q][j].z * rstd, v[q][j].w * rstd) << 32); }
}
__device__ __forceinline__ void copy_shift(const float* src, float* dst, int nb, int rows, int rowf, long gtid, long gthreads) {
    const long per = (long)(rows - 1) * rowf / 4, tot = per * nb;
    for (long i0 = gtid; i0 < tot; i0 += 4 * gthreads) {
        f32x4 v[4]; long o[4];
#pragma unroll
        for (int k = 0; k < 4; ++k) { const long i = i0 + k * gthreads; const long ic = i < tot ? i : tot - 1; const long n = ic / per, off = ic - n * per; o[k] = n * (long)rows * rowf / 4 + off;
            v[k] = __builtin_nontemporal_load((const f32x4*)(src + rowf) + o[k]); }
#pragma unroll
        for (int k = 0; k < 4; ++k) __builtin_nontemporal_store(v[k], (f32x4*)dst + o[k]);
    }
}
__device__ __forceinline__ void p0_prologue(Frame& F) {
    LAS float* scr = (LAS float*)(F.lds + F.wave * 16384);
    const int gw = F.vcu * NWAVES + F.wave, NGW = F.G * NWAVES;
    constexpr int I_IN = 16 * 72, I_OUT = 16 * 32, I_XQ = 16 * 32, I_MKV = 16 * 64, I_XO = 16 * 32, I_UP = 16 * 176, I_DN = 44 * 32;
    constexpr int NITEMS = I_IN + I_OUT + I_XQ + I_MKV + I_XO + I_UP + I_DN;
    for (int it = gw; it < NITEMS; it += NGW) {
        int r = it;
        if (r < I_IN) { p0_transpose_item(inptr(11), 1024, 2304, ((bf16*)(F.ws + WS_WIN)), inptr(10), inptr(10), 1024, 1, scr, r, FLANE); continue; } r -= I_IN;
        if (r < I_OUT) { p0_transpose_item(inptr(15), 1024, 1024, ((bf16*)(F.ws + WS_WOUT)), inptr(12), inptr(13), 512, 0, scr, r, FLANE); continue; } r -= I_OUT;
        if (r < I_XQ) { p0_transpose_item(inptr(18), 1024, 1024, ((bf16*)(F.ws + WS_WXQ)), inptr(16), inptr(16), 1024, 0, scr, r, FLANE); continue; } r -= I_XQ;
        if (r < I_MKV) { p0_transpose_item(inptr(19), 1024, 2048, ((bf16*)(F.ws + WS_WMKV)), inptr(17), inptr(17), 1024, 0, scr, r, FLANE); continue; } r -= I_MKV;
        if (r < I_XO) { p0_transpose_item(inptr(20), 1024, 1024, ((bf16*)(F.ws + WS_WXO)), nullptr, nullptr, 0, 0, scr, r, FLANE); continue; } r -= I_XO;
        if (r < I_UP) { p0_transpose_item(inptr(22), 1024, 5632, ((bf16*)(F.ws + WS_WUP)), inptr(21), inptr(21), 1024, 2, scr, r, FLANE); continue; } r -= I_UP;
        p0_transpose_item(inptr(25), 2816, 1024, ((bf16*)(F.ws + WS_WDN)), nullptr, nullptr, 0, 0, scr, r, FLANE);
    }
    const float* xp_ = inptr(0); const float* xs_ = inptr(1); const float* mp_ = inptr(9);
    constexpr int NROWS = MT + NB * MEMT;
    for (int m0 = gw; m0 < NROWS; m0 += 4 * NGW) {
        const float* xr[4]; bf16* orw[4];
#pragma unroll
        for (int q = 0; q < 4; ++q) { const int m = m0 + q * NGW < NROWS ? m0 + q * NGW : NROWS - 1;
            if (m < MP) { xr[q] = xp_ + (size_t)m * D; orw[q] = ((bf16*)(F.ws + WS_XN)) + (size_t)m * D; }
            else if (m < MT) { xr[q] = xs_ + (size_t)(m - MP) * D; orw[q] = ((bf16*)(F.ws + WS_XN)) + (size_t)m * D; }
            else { xr[q] = mp_ + (size_t)(m - MT) * D; orw[q] = ((bf16*)(F.ws + WS_MEMN)) + (size_t)(m - MT) * D; } }
        rms_rows4_to_bf16(FLANE, xr, orw);
    }
    const long gtid = (long)F.vcu * (NWAVES * 64) + FTID, gthreads = (long)F.G * (NWAVES * 64);
    if (gtid < NS * 16) { ((float*)(F.ws + WS_SSQ1))[(size_t)MP * 16 + gtid] = 0.f; ((float*)(F.ws + WS_SSQ2))[(size_t)MP * 16 + gtid] = 0.f; ((float*)(F.ws + WS_SSQ3))[(size_t)MP * 16 + gtid] = 0.f; }
    {
        const pg8::KCopy kc{(const char*)inptr(2), (const char*)inptr(3), (char*)(F.out + O_SAK), (char*)(F.out + O_SAV), 0, 1 << 30, 0, 1, 0u, 0, 1};
        const int ln = FLANE;
        for (unsigned c0 = (unsigned)(RIDER_CHUNKS + 2 * (SWA_NU_HOST / F.G)) * (unsigned)NGW + (unsigned)gw; c0 < COPY_CHUNKS; c0 += 16u * (unsigned)NGW) {
            f32x4 v[16]; char* dp[16];
#pragma unroll
            for (int k = 0; k < 16; ++k) { unsigned cid = c0 + (unsigned)k * (unsigned)NGW; cid = cid < COPY_CHUNKS ? cid : COPY_CHUNKS - 1u; const char* sp; kc.addr((int)cid, sp, dp[k]);
                v[k] = __builtin_nontemporal_load((const f32x4*)sp + ln); }
#pragma unroll
            for (int k = 0; k < 16; ++k) __builtin_nontemporal_store(v[k], (f32x4*)dp[k] + ln);
        }
    }
    copy_shift(inptr(4), F.out + O_SBK, NS, LB, 128, gtid, gthreads);
    copy_shift(inptr(5), F.out + O_SBV, NS, LB, 128, gtid, gthreads);
    copy_shift(inptr(8), F.out + O_SCV, NS, 2, DFF, gtid, gthreads);
}

struct SwaUnit { int kind, b, h, d, rho, i0; };
constexpr int SWA_NU = 3 * 2048 + 512;
__device__ __forceinline__ SwaUnit swa_decode(int U) {
    SwaUnit u;
    if (U >= 3 * 2048) { const int rem = U - 3 * 2048; u.kind = 3; u.b = rem >> 6; u.h = (rem >> 5) & 1; u.d = 1; u.rho = 0; u.i0 = (rem & 31) * 128; }
    else { u.kind = U >> 11; const int rem = U & 2047; u.b = rem >> 8; u.h = (rem >> 5) & 7; const int r5 = rem & 31;
        u.d = 1 << (2 * u.kind); const int nblk = 32 >> (2 * u.kind); u.rho = r5 / nblk; u.i0 = (r5 % nblk) * 128; }
    return u;
}
__device__ __forceinline__ void swa_stage(Frame& F, const SwaUnit& u, int buf, int lane) {
    const bool isB = u.kind == 3;
    const int kcol = isB ? 2048 + u.h * 64 : 512 + u.h * 64, vcol = isB ? 2176 + u.h * 64 : 1024 + u.h * 64;
    const bf16* Zb = ((bf16*)(F.ws + WS_Z)) + (size_t)u.b * S * ZP;
    LAS unsigned char* base = F.lds + buf * 65536;
#pragma unroll
    for (int i = 0; i < 4; ++i) {
        const int piece = F.wave * 4 + i, row = piece * 8 + (lane >> 3), cpos = lane & 7;
        int idx = u.i0 - 128 + row; idx = idx < 0 ? 0 : idx;
        const bf16* rp = Zb + (size_t)(u.rho + u.d * idx) * ZP;
        const int ck = cpos ^ (row & 7), cv = 2 * ((cpos >> 1) ^ ((row >> 1) & 3)) + (cpos & 1);
        __builtin_amdgcn_global_load_lds((const unsigned*)(rp + kcol + ck * 8), (LAS unsigned*)(base + piece * 1024), 16, 0, 0);
        __builtin_amdgcn_global_load_lds((const unsigned*)(rp + vcol + cv * 8), (LAS unsigned*)(base + 32768 + piece * 1024), 16, 0, 0);
    }
}
__device__ __forceinline__ void swa_compute(Frame& F, const SwaUnit& u, int buf, int lane, const bf16x8 (&qf)[2], float sinkv, int hq  ) {
    const int c = lane & 15, g = lane >> 4, w = F.wave;
    LAS const unsigned char* kb = F.lds + buf * 65536;
    LAS const unsigned char* vb = kb + 32768;
    f32x4 sc[9];
#pragma unroll
    for (int T = 0; T < 9; ++T) {
        const int row = 16 * (w + T) + c;
        f32x4 a = (f32x4){0.f, 0.f, 0.f, 0.f};
#pragma unroll
        for (int ks = 0; ks < 2; ++ks) { const bf16x8 kf = *(LAS const bf16x8*)(kb + row * 128 + (((ks * 4 + g) ^ (row & 7)) * 16));
            a = __builtin_amdgcn_mfma_f32_16x16x32_bf16(kf, qf[ks], a, 0, 0, 0); }
#pragma unroll
        for (int i = 0; i < 4; ++i) { const int diff = 128 + c - 16 * T - 4 * g - i; const int kidx = u.i0 - 128 + 16 * (w + T) + 4 * g + i;
            const bool valid = (diff >= 0) && (diff <= 128) && (kidx >= 0);
            a[i] = valid ? a[i] : NEGBIG; }
        sc[T] = a;
    }
    float m = NEGBIG;
#pragma unroll
    for (int T = 0; T < 9; ++T)
#pragma unroll
        for (int i = 0; i < 4; ++i) m = fmaxf(m, sc[T][i]);
    m = fmaxf(m, __shfl_xor(m, 16)); m = fmaxf(m, __shfl_xor(m, 32));
    float l = 0.f;
#pragma unroll
    for (int T = 0; T < 9; ++T)
#pragma unroll
        for (int i = 0; i < 4; ++i) { const float p = __builtin_amdgcn_exp2f(sc[T][i] - m); sc[T][i] = p; l += p; }
    l += __shfl_xor(l, 16); l += __shfl_xor(l, 32);
    bf16x8 pb[5];
#pragma unroll
    for (int j = 0; j < 5; ++j) { v4u wv;
        wv.x = pg8::cvt_pk_bf16(sc[2 * j][0], sc[2 * j][1]); wv.y = pg8::cvt_pk_bf16(sc[2 * j][2], sc[2 * j][3]);
        if (j < 4) { wv.z = pg8::cvt_pk_bf16(sc[2 * j + 1][0], sc[2 * j + 1][1]); wv.w = pg8::cvt_pk_bf16(sc[2 * j + 1][2], sc[2 * j + 1][3]); } else { wv.z = 0u; wv.w = 0u; }
        pb[j] = __builtin_bit_cast(bf16x8, wv); }
    f32x4 o[4];
#pragma unroll
    for (int dt = 0; dt < 4; ++dt) o[dt] = (f32x4){0.f, 0.f, 0.f, 0.f};
    {
        const int q = (lane & 15) >> 2, pp = lane & 3, rl = 4 * g + q;
        unsigned va[4];
#pragma unroll
        for (int dt = 0; dt < 4; ++dt) va[dt] = lds_addr(vb) + (unsigned)(2048 * w + rl * 128 + ((dt ^ ((rl >> 1) & 3)) * 32) + pp * 8);
        const s16x4 z4 = (s16x4){0, 0, 0, 0};
#define SWA_PV(j) do { s16x4 lo_[4], hh_[4]; \
        VTRA(lo_[0], va[0], (j) * 4096); VTRA(lo_[1], va[1], (j) * 4096); VTRA(lo_[2], va[2], (j) * 4096); VTRA(lo_[3], va[3], (j) * 4096); \
        if ((j) < 4) { VTRA(hh_[0], va[0], (j) * 4096 + 2048); VTRA(hh_[1], va[1], (j) * 4096 + 2048); VTRA(hh_[2], va[2], (j) * 4096 + 2048); VTRA(hh_[3], va[3], (j) * 4096 + 2048); } \
        else { hh_[0] = z4; hh_[1] = z4; hh_[2] = z4; hh_[3] = z4; } \
        LGKM0(); \
        _Pragma("unroll") for (int dt = 0; dt < 4; ++dt) { const bf16x8 vf = (bf16x8){lo_[dt][0], lo_[dt][1], lo_[dt][2], lo_[dt][3], hh_[dt][0], hh_[dt][1], hh_[dt][2], hh_[dt][3]}; \
            o[dt] = __builtin_amdgcn_mfma_f32_16x16x32_bf16(vf, pb[j], o[dt], 0, 0, 0); } } while (0)
        SWA_PV(0); SWA_PV(1); SWA_PV(2); SWA_PV(3); SWA_PV(4);
#undef SWA_PV
    }
    const bool isB = u.kind == 3;
    float linv = 1.0f / l; const float lse2 = m + __builtin_amdgcn_logf(l);
    if (isB) linv *= 1.0f / (1.0f + __builtin_amdgcn_exp2f(sinkv * LOG2E - lse2));
    const int tq = u.rho + u.d * (u.i0 + 16 * w + c);
    bf16* dst = (isB ? ((bf16*)(F.ws + WS_OB)) : ((bf16*)(F.ws + WS_PO)) + (size_t)u.kind * MP * 512) + ((size_t)u.b * S + tq) * 512 + hq * 64 + 4 * g;
#pragma unroll
    for (int dt = 0; dt < 4; ++dt) { u32x2v wv; wv.x = pg8::cvt_pk_bf16(o[dt][0] * linv, o[dt][1] * linv); wv.y = pg8::cvt_pk_bf16(o[dt][2] * linv, o[dt][3] * linv); *(u32x2v*)(dst + 16 * dt) = wv; }
    if (!isB && g == 0) ((float*)(F.ws + WS_PL))[(size_t)u.kind * MP * 8 + ((size_t)u.b * S + tq) * 8 + hq] = lse2;
}
__device__ __forceinline__ void swa_load_q(Frame& F, const SwaUnit& u, int lane, bf16x8 (&qf)[4][2], float (&sinkv)[4]) {
    const int c = lane & 15, g = lane >> 4; const bool isB = u.kind == 3;
    const bf16* qp = ((bf16*)(F.ws + WS_Z)) + ((size_t)u.b * S + u.rho + u.d * (u.i0 + 16 * F.wave + c)) * ZP + (isB ? 1536 + u.h * 256 : u.h * 64) + 8 * g;
    const float* sk = inptr(14) + (isB ? u.h * 4 : 0);
    qf[0][0] = *(const bf16x8*)qp; qf[0][1] = *(const bf16x8*)(qp + 32); sinkv[0] = sk[0];
    if (isB) {
#pragma unroll
        for (int hs = 1; hs < 4; ++hs) { qf[hs][0] = *(const bf16x8*)(qp + hs * 64); qf[hs][1] = *(const bf16x8*)(qp + hs * 64 + 32); sinkv[hs] = sk[hs]; }
    }
}
__device__ __forceinline__ void sample_attn_unit(Frame& F, int su) {
    const int lane = FLANE, li = lane & 15, lg = lane >> 4;
    const bool isB = su >= 3072;
    int n, hh, seg = 0;
    if (!isB) { seg = su % 3; const int t = su / 3; hh = t & 7; n = t >> 3; } else { const int t = su - 3072; hh = t & 7; n = t >> 3; }
    const bf16* zrow = ((bf16*)(F.ws + WS_Z)) + (size_t)(MP + n) * ZP;
    int qcol, kcol, vcol, rs; const float *Kc, *Vc;
    if (!isB) { qcol = hh * 64; kcol = 512 + hh * 64; vcol = 1024 + hh * 64; rs = 512; Kc = inptr(2) + (size_t)n * LA * 512 + hh * 64; Vc = inptr(3) + (size_t)n * LA * 512 + hh * 64; }
    else { const int g = hh >> 2; qcol = 1536 + hh * 64; kcol = 2048 + g * 64; vcol = 2176 + g * 64; rs = 128; Kc = inptr(4) + (size_t)n * LB * 128 + g * 64; Vc = inptr(5) + (size_t)n * LB * 128 + g * 64; }
    float q4[4], kn[4], vn[4];
    { const u32x2v a = *(const u32x2v*)(zrow + qcol + 4 * li), k2 = *(const u32x2v*)(zrow + kcol + 4 * li), v2 = *(const u32x2v*)(zrow + vcol + 4 * li);
      q4[0] = bflo(a.x); q4[1] = bfhi(a.x); q4[2] = bflo(a.y); q4[3] = bfhi(a.y);
      kn[0] = bflo(k2.x); kn[1] = bfhi(k2.x); kn[2] = bflo(k2.y); kn[3] = bfhi(k2.y);
      vn[0] = bflo(v2.x); vn[1] = bfhi(v2.x); vn[2] = bflo(v2.y); vn[3] = bfhi(v2.y); }
    const int step = 1 << (2 * seg);
    float sv[32];
    float mx = NEGBIG;
#pragma unroll
    for (int it = 0; it < 32; ++it) { const int j = 4 * it + lg; const int row = isB ? j : (LA - step * (j + 1));
        const f32x4 kv = __builtin_nontemporal_load((const f32x4*)(Kc + (size_t)row * rs + 4 * li));
        float sx = (q4[0] * kv[0] + q4[1] * kv[1]) + (q4[2] * kv[2] + q4[3] * kv[3]);
        sx += __shfl_xor(sx, 1); sx += __shfl_xor(sx, 2); sx += __shfl_xor(sx, 4); sx += __shfl_xor(sx, 8);
        sv[it] = sx; mx = fmaxf(mx, sx); }
    float snew = (q4[0] * kn[0] + q4[1] * kn[1]) + (q4[2] * kn[2] + q4[3] * kn[3]);
    snew += __shfl_xor(snew, 1); snew += __shfl_xor(snew, 2); snew += __shfl_xor(snew, 4); snew += __shfl_xor(snew, 8);
    mx = fmaxf(mx, snew); mx = fmaxf(mx, __shfl_xor(mx, 16)); mx = fmaxf(mx, __shfl_xor(mx, 32));
    float o4[4] = {0.f, 0.f, 0.f, 0.f}, l = 0.f;
#pragma unroll
    for (int it = 0; it < 32; ++it) { const int j = 4 * it + lg; const int row = isB ? j : (LA - step * (j + 1));
        const float p = __builtin_amdgcn_exp2f(sv[it] - mx); l += p;
        const f32x4 vv = __builtin_nontemporal_load((const f32x4*)(Vc + (size_t)row * rs + 4 * li));
        o4[0] += p * vv[0]; o4[1] += p * vv[1]; o4[2] += p * vv[2]; o4[3] += p * vv[3]; }
#pragma unroll
    for (int c = 0; c < 4; ++c) { o4[c] += __shfl_xor(o4[c], 16); o4[c] += __shfl_xor(o4[c], 32); }
    l += __shfl_xor(l, 16); l += __shfl_xor(l, 32);
    const float pn = __builtin_amdgcn_exp2f(snew - mx);
    l += pn;
#pragma unroll
    for (int c = 0; c < 4; ++c) o4[c] += pn * vn[c];
    float scale = 1.0f / l; const float lse2 = mx + __builtin_amdgcn_logf(l);
    if (isB) scale *= 1.0f / (1.0f + __builtin_amdgcn_exp2f(inptr(14)[hh] * LOG2E - lse2));
    float* so = ((float*)(F.ws + WS_SO)) + (isB ? (size_t)3 * NS * 512 : (size_t)seg * NS * 512) + (size_t)n * 512 + hh * 64 + 4 * li;
    if (lg == 0) *(f32x4*)so = (f32x4){o4[0] * scale, o4[1] * scale, o4[2] * scale, o4[3] * scale};
    if (!isB && lane == 0) ((float*)(F.ws + WS_SSQ3 + 5 * 512 * 1024))[((size_t)seg * NS + n) * 8 + hh] = lse2;
}
__device__ __forceinline__ void p2_attention(Frame& F) {
    const int lane = FLANE;
    constexpr int NU = SWA_NU;
    int U = F.vcu, k = 0;
    const pg8::KCopy kc{(const char*)inptr(2), (const char*)inptr(3), (char*)(F.out + O_SAK), (char*)(F.out + O_SAV), 0, 1 << 30, 0, 1, 0u, 0, 1};
    bf16x8 qcur[4][2], qnxt[4][2]; float scur[4], snxt[4];
    if (U < NU) { const SwaUnit u0 = swa_decode(U); swa_load_q(F, u0, lane, qcur, scur); swa_stage(F, u0, 0, lane); }
    for (; U < NU; U += F.G, ++k) {
        const SwaUnit u = swa_decode(U);
        __syncthreads();
        const int Un = U + F.G;
        f32x4 cpv[2]; char* cpd[2];
#pragma unroll
        for (int e = 0; e < 2; ++e) { const char* sp; kc.addr_id((unsigned)(RIDER_CHUNKS + 2 * k + e) * (unsigned)(F.G * NWAVES) + (unsigned)(F.vcu * NWAVES + F.wave), sp, cpd[e]); cpv[e] = __builtin_nontemporal_load((const f32x4*)sp + lane); }
        if (Un < NU) { const SwaUnit un = swa_decode(Un); swa_load_q(F, un, lane, qnxt, snxt); swa_stage(F, un, (k + 1) & 1, lane); }
        if (u.kind == 3) {
            swa_compute(F, u, k & 1, lane, qcur[0], scur[0], u.h * 4 + 0); swa_compute(F, u, k & 1, lane, qcur[1], scur[1], u.h * 4 + 1);
            swa_compute(F, u, k & 1, lane, qcur[2], scur[2], u.h * 4 + 2); swa_compute(F, u, k & 1, lane, qcur[3], scur[3], u.h * 4 + 3);
        } else swa_compute(F, u, k & 1, lane, qcur[0], scur[0], u.h);
#pragma unroll
        for (int e = 0; e < 2; ++e) __builtin_nontemporal_store(cpv[e], (f32x4*)cpd[e] + lane);
#pragma unroll
        for (int hs = 0; hs < 4; ++hs) { qcur[hs][0] = qnxt[hs][0]; qcur[hs][1] = qnxt[hs][1]; scur[hs] = snxt[hs]; }
    }
    __syncthreads();
    const int gw = F.vcu * NWAVES + F.wave, NGW = F.G * NWAVES;
    for (int su = gw; su < 4096; su += NGW) sample_attn_unit(F, su);
}
__device__ __forceinline__ void unpack8(const v4u v, float (&f)[8]) { f[0] = bflo(v.x); f[1] = bfhi(v.x); f[2] = bflo(v.y); f[3] = bfhi(v.y); f[4] = bflo(v.z); f[5] = bfhi(v.z); f[6] = bflo(v.w); f[7] = bfhi(v.w); }
__device__ __forceinline__ void ld8f(const float* p, float (&f)[8]) { const f32x4 a = *(const f32x4*)p, b = *(const f32x4*)(p + 4); f[0] = a[0]; f[1] = a[1]; f[2] = a[2]; f[3] = a[3]; f[4] = b[0]; f[5] = b[1]; f[6] = b[2]; f[7] = b[3]; }
__device__ __forceinline__ void mix_store(Frame& F, int r, int lane, const float (&a)[8], const float (&bb)[8]) {
    float sa = 0.f, sb = 0.f;
#pragma unroll
    for (int e = 0; e < 8; ++e) { sa += a[e] * a[e]; sb += bb[e] * bb[e]; }
    const float ra = 1.0f / sqrtf(wave_sum(sa) * (1.0f / 512.0f) + EPS), rb = 1.0f / sqrtf(wave_sum(sb) * (1.0f / 512.0f) + EPS);
    v4u oa, ob;
    oa.x = pk2(a[0] * ra, a[1] * ra); oa.y = pk2(a[2] * ra, a[3] * ra); oa.z = pk2(a[4] * ra, a[5] * ra); oa.w = pk2(a[6] * ra, a[7] * ra);
    ob.x = pk2(bb[0] * rb, bb[1] * rb); ob.y = pk2(bb[2] * rb, bb[3] * rb); ob.z = pk2(bb[4] * rb, bb[5] * rb); ob.w = pk2(bb[6] * rb, bb[7] * rb);
    *(v4u*)(((bf16*)(F.ws + WS_OC)) + (size_t)r * D + lane * 8) = oa; *(v4u*)(((bf16*)(F.ws + WS_OC)) + (size_t)r * D + 512 + lane * 8) = ob;
}
__device__ __forceinline__ void p3_mix(Frame& F) {
    const int gw = F.vcu * NWAVES + F.wave, NGW = F.G * NWAVES, lane = FLANE, head = lane >> 3;
    for (int r0 = gw; r0 < MP; r0 += 4 * NGW) {
        v4u po[4][3], obv[4]; float ls[4][3];
#pragma unroll
        for (int q = 0; q < 4; ++q) { const int r = r0 + q * NGW < MP ? r0 + q * NGW : MP - 1;
#pragma unroll
            for (int k = 0; k < 3; ++k) { ls[q][k] = ((float*)(F.ws + WS_PL))[(size_t)k * MP * 8 + (size_t)r * 8 + head]; po[q][k] = *(const v4u*)(((bf16*)(F.ws + WS_PO)) + (size_t)k * MP * 512 + (size_t)r * 512 + lane * 8); }
            obv[q] = *(const v4u*)(((bf16*)(F.ws + WS_OB)) + (size_t)r * 512 + lane * 8); }
#pragma unroll
        for (int q = 0; q < 4; ++q) { const int r = r0 + q * NGW < MP ? r0 + q * NGW : MP - 1;
            const float mxl = fmaxf(fmaxf(ls[q][0], ls[q][1]), ls[q][2]);
            float w[3], ws = 0.f;
#pragma unroll
            for (int k = 0; k < 3; ++k) { w[k] = __builtin_amdgcn_exp2f(ls[q][k] - mxl); ws += w[k]; }
            const float wi = 1.0f / ws;
            float a[8], bb[8];
#pragma unroll
            for (int e = 0; e < 8; ++e) a[e] = 0.f;
#pragma unroll
            for (int k = 0; k < 3; ++k) { const v4u v = po[q][k]; const float wk = w[k] * wi;
                a[0] += wk * bflo(v.x); a[1] += wk * bfhi(v.x); a[2] += wk * bflo(v.y); a[3] += wk * bfhi(v.y); a[4] += wk * bflo(v.z); a[5] += wk * bfhi(v.z); a[6] += wk * bflo(v.w); a[7] += wk * bfhi(v.w); }
            unpack8(obv[q], bb);
            mix_store(F, r, lane, a, bb); }
    }
    for (int r = MP + gw; r < MT; r += NGW) {
        const int n = r - MP;
        const float* SL = (const float*)(F.ws + WS_SSQ3 + 5 * 512 * 1024);
        float ls[3], mxl = NEGBIG;
#pragma unroll
        for (int k = 0; k < 3; ++k) { ls[k] = SL[((size_t)k * NS + n) * 8 + head]; mxl = fmaxf(mxl, ls[k]); }
        float w[3], wsum = 0.f;
#pragma unroll
        for (int k = 0; k < 3; ++k) { w[k] = __builtin_amdgcn_exp2f(ls[k] - mxl); wsum += w[k]; }
        const float wi = 1.0f / wsum;
        float a[8], bb[8];
#pragma unroll
        for (int e = 0; e < 8; ++e) a[e] = 0.f;
#pragma unroll
        for (int k = 0; k < 3; ++k) { const float* so = ((const float*)(F.ws + WS_SO)) + ((size_t)k * NS + n) * 512 + lane * 8; const f32x4 a0 = *(const f32x4*)so, a1 = *(const f32x4*)(so + 4); const float wk = w[k] * wi;
            a[0] += wk * a0[0]; a[1] += wk * a0[1]; a[2] += wk * a0[2]; a[3] += wk * a0[3]; a[4] += wk * a1[0]; a[5] += wk * a1[1]; a[6] += wk * a1[2]; a[7] += wk * a1[3]; }
        ld8f(((const float*)(F.ws + WS_SO)) + ((size_t)3 * NS + n) * 512 + lane * 8, bb);
        mix_store(F, r, lane, a, bb);
    }
}
__device__ __forceinline__ void cross_stage_q(Frame& F, int b, int hx, int quarter, int buf, int lane) {
    const bf16* MKp = (const bf16*)(F.ws + WS_MK); const bf16* MVp = (const bf16*)(F.ws + WS_MV);
#pragma unroll
    for (int i = 0; i < 4; ++i) {
        const int piece = F.wave * 4 + i, row = piece * 2 + (lane >> 5), cpos = lane & 31;
        const int ck = cpos ^ (row & 15), cv = 2 * ((cpos >> 1) ^ (row & 7)) + (cpos & 1);
        const size_t grow = (size_t)(b * 256 + quarter * 64 + row) * 1024 + hx * 256;
        __builtin_amdgcn_global_load_lds((const unsigned*)(MKp + grow + ck * 8), (LAS unsigned*)(F.lds + buf * 65536 + piece * 1024), 16, 0, 0);
        __builtin_amdgcn_global_load_lds((const unsigned*)(MVp + grow + cv * 8), (LAS unsigned*)(F.lds + buf * 65536 + 32768 + piece * 1024), 16, 0, 0);
    }
}
__device__ __forceinline__ void cross_load_q(Frame& F, int b, int hx, int q0, int lane, bf16x8 (&qf)[8]) {
    const bf16* qp = ((const bf16*)(F.ws + WS_QX)) + ((size_t)b * S + q0 + F.wave * 16 + (lane & 15)) * 1024 + hx * 256 + 8 * (lane >> 4);
#pragma unroll
    for (int ks = 0; ks < 8; ++ks) qf[ks] = *(const bf16x8*)(qp + ks * 32);
}
__device__ __forceinline__ void cross_cu(Frame& F, int b, int hx, int qbase, int lane_in) {
    int lane = lane_in; asm volatile("" : "+v"(lane));
    const int c = lane & 15, g = lane >> 4, q = (lane & 15) >> 2, pp = lane & 3, rl = 4 * g + q;
    int kx[8], vx[16];
#pragma unroll
    for (int ks = 0; ks < 8; ++ks) kx[ks] = c * 512 + (((ks * 4 + g) ^ c) * 16);
#pragma unroll
    for (int dt = 0; dt < 16; ++dt) vx[dt] = 32768 + rl * 512 + pp * 8 + ((dt ^ (rl & 7)) * 32);
    bf16x8 qf[8], qn[8];
    cross_load_q(F, b, hx, qbase, lane, qf);
    cross_stage_q(F, b, hx, 0, 0, lane);
    int st = 0;
#pragma unroll 1
    for (int ps = 0; ps < 4; ++ps) {
        float m = NEGBIG, l = 0.f; f32x4 o[16];
#pragma unroll
        for (int dt = 0; dt < 16; ++dt) o[dt] = (f32x4){0.f, 0.f, 0.f, 0.f};
#pragma unroll 1
        for (int qd = 0; qd < 4; ++qd, ++st) {
            __syncthreads();
            if (qd == 3 && ps < 3) cross_load_q(F, b, hx, qbase + (ps + 1) * 128, lane, qn);
            if (!(qd == 3 && ps == 3)) cross_stage_q(F, b, hx, (qd + 1) & 3, (st + 1) & 1, lane);
#pragma unroll 1
            for (int jj = 0; jj < 2; ++jj) {
                LAS const unsigned char* base = F.lds + (st & 1) * 65536 + jj * 16384;
                f32x4 s0 = (f32x4){0.f, 0.f, 0.f, 0.f}, s1 = (f32x4){0.f, 0.f, 0.f, 0.f};
#pragma unroll
                for (int ks = 0; ks < 8; ++ks) { const bf16x8 k0 = *(LAS const bf16x8*)(base + kx[ks]), k1 = *(LAS const bf16x8*)(base + 8192 + kx[ks]);
                    s0 = __builtin_amdgcn_mfma_f32_16x16x32_bf16(k0, qf[ks], s0, 0, 0, 0); s1 = __builtin_amdgcn_mfma_f32_16x16x32_bf16(k1, qf[ks], s1, 0, 0, 0); }
                float tm = fmaxf(fmaxf(fmaxf(s0[0], s0[1]), fmaxf(s0[2], s0[3])), fmaxf(fmaxf(s1[0], s1[1]), fmaxf(s1[2], s1[3])));
                tm = fmaxf(tm, __shfl_xor(tm, 16)); tm = fmaxf(tm, __shfl_xor(tm, 32));
                const float mn = fmaxf(m, tm), alpha = __builtin_amdgcn_exp2f(m - mn); m = mn;
                float p0[4], p1[4], psum = 0.f;
#pragma unroll
                for (int i = 0; i < 4; ++i) { p0[i] = __builtin_amdgcn_exp2f(s0[i] - mn); p1[i] = __builtin_amdgcn_exp2f(s1[i] - mn); psum += p0[i] + p1[i]; }
                l = l * alpha + psum;
#pragma unroll
                for (int dt = 0; dt < 16; ++dt) o[dt] = o[dt] * alpha;
                const bf16x8 pb = __builtin_bit_cast(bf16x8, (v4u){pg8::cvt_pk_bf16(p0[0], p0[1]), pg8::cvt_pk_bf16(p0[2], p0[3]), pg8::cvt_pk_bf16(p1[0], p1[1]), pg8::cvt_pk_bf16(p1[2], p1[3])});
                const unsigned vbase = lds_addr(base);
#pragma unroll
                for (int d4 = 0; d4 < 4; ++d4) {
                    s16x4 lo_[4], hh_[4];
#pragma unroll
                    for (int e = 0; e < 4; ++e) { const unsigned a_ = vbase + (unsigned)vx[4 * d4 + e]; VTRA(lo_[e], a_, 0); VTRA(hh_[e], a_, 8192); }
                    LGKM0();
#pragma unroll
                    for (int e = 0; e < 4; ++e) { const bf16x8 vf = (bf16x8){lo_[e][0], lo_[e][1], lo_[e][2], lo_[e][3], hh_[e][0], hh_[e][1], hh_[e][2], hh_[e][3]};
                        o[4 * d4 + e] = __builtin_amdgcn_mfma_f32_16x16x32_bf16(vf, pb, o[4 * d4 + e], 0, 0, 0); }
                }
            }
        }
        float lt = l; lt += __shfl_xor(lt, 16); lt += __shfl_xor(lt, 32); const float linv = 1.0f / lt;
        bf16* op = ((bf16*)(F.ws + WS_OX)) + ((size_t)b * S + qbase + ps * 128 + F.wave * 16 + c) * 1024 + hx * 256 + 4 * g;
#pragma unroll
        for (int dt = 0; dt < 16; ++dt) { u32x2v wv; wv.x = pg8::cvt_pk_bf16(o[dt][0] * linv, o[dt][1] * linv); wv.y = pg8::cvt_pk_bf16(o[dt][2] * linv, o[dt][3] * linv); *(u32x2v*)(op + 16 * dt) = wv; }
#pragma unroll
        for (int ks = 0; ks < 8; ++ks) qf[ks] = qn[ks];
    }
    __syncthreads();
}
__device__ __forceinline__ void cross_sample_unit(Frame& F, int n, int hx) {
    const int lane = FLANE, w = F.wave;
    LAS float* scs = (LAS float*)F.lds;
    LAS float* part = (LAS float*)(F.lds + 1024);
    float q4[4];
    { const u32x2v a = *(const u32x2v*)(((bf16*)(F.ws + WS_QX)) + (size_t)(MP + n) * 1024 + hx * 256 + 4 * lane); q4[0] = bflo(a.x); q4[1] = bfhi(a.x); q4[2] = bflo(a.y); q4[3] = bfhi(a.y); }
    const float* Kc = inptr(6) + ((size_t)n * MEMT * 4 + hx) * 256 + 4 * lane;
    const float* Vc = inptr(7) + ((size_t)n * MEMT * 4 + hx) * 256 + 4 * lane;
#pragma unroll 8
    for (int kk = 0; kk < 32; ++kk) { const int key = w * 32 + kk; const f32x4 kv = __builtin_nontemporal_load((const f32x4*)(Kc + (size_t)key * 1024));
        float s = (q4[0] * kv[0] + q4[1] * kv[1]) + (q4[2] * kv[2] + q4[3] * kv[3]); s = wave_sum(s);
        if (lane == 0) scs[key] = s; }
    __syncthreads();
    const f32x4 s4 = *(LAS const f32x4*)(scs + 4 * lane);
    float mx = fmaxf(fmaxf(s4[0], s4[1]), fmaxf(s4[2], s4[3]));
#pragma unroll
    for (int o = 1; o < 64; o <<= 1) mx = fmaxf(mx, __shfl_xor(mx, o));
    float l = __builtin_amdgcn_exp2f(s4[0] - mx) + __builtin_amdgcn_exp2f(s4[1] - mx) + __builtin_amdgcn_exp2f(s4[2] - mx) + __builtin_amdgcn_exp2f(s4[3] - mx);
    l = wave_sum(l);
    float o4[4] = {0.f, 0.f, 0.f, 0.f};
#pragma unroll 8
    for (int kk = 0; kk < 32; ++kk) { const int key = w * 32 + kk; const float p = __builtin_amdgcn_exp2f(scs[key] - mx); const f32x4 vv = __builtin_nontemporal_load((const f32x4*)(Vc + (size_t)key * 1024));
        o4[0] += p * vv[0]; o4[1] += p * vv[1]; o4[2] += p * vv[2]; o4[3] += p * vv[3]; }
    *(LAS f32x4*)(part + w * 256 + 4 * lane) = (f32x4){o4[0], o4[1], o4[2], o4[3]};
    __syncthreads();
    if (FTID < 256) { float s = 0.f;
#pragma unroll
        for (int k = 0; k < 8; ++k) s += part[k * 256 + FTID];
        ((bf16*)(F.ws + WS_OX))[(size_t)(MP + n) * 1024 + hx * 256 + FTID] = (bf16)f2bf(s / l); }
    __syncthreads();
}
#ifndef XNQT
#define XNQT 1
#endif
__device__ __forceinline__ void p6_cross(Frame& F) {
    const int lane = FLANE;
    for (int du = F.vcu; du < 256; du += F.G) {
        const int pair = du >> 3, b = pair >> 2, hx = pair & 3;
        cross_cu(F, b, hx, 512 * (du & 7), lane);
    }
    __syncthreads();
    for (int u = F.vcu; u < NS * 4; u += F.G) cross_sample_unit(F, u >> 2, u & 3);
}
__device__ __forceinline__ void conv_row(const float (&g0)[8], const float (&g1)[8], const float (&g2)[8], const float (&vl)[8], const float (&w0)[8], const float (&w1)[8], const float (&w2)[8], const float (&cb)[8], bf16* dst) {
    float a[8];
#pragma unroll
    for (int e = 0; e < 8; ++e) { const float c = cb[e] + w0[e] * g0[e] + w1[e] * g1[e] + w2[e] * g2[e]; a[e] = c / (1.0f + __builtin_amdgcn_exp2f(-c * LOG2E)) * vl[e]; }
    v4u o; o.x = pk2(a[0], a[1]); o.y = pk2(a[2], a[3]); o.z = pk2(a[4], a[5]); o.w = pk2(a[6], a[7]);
    *(v4u*)dst = o;
}
__device__ __forceinline__ void p9_conv(Frame& F) {
    const long gtid = (long)F.vcu * (NWAVES * 64) + FTID, gthreads = (long)F.G * (NWAVES * 64);
    constexpr int CH = DFF / 8;
    const float* stc_ = inptr(8); const float* cw_ = inptr(23); const float* cbp_ = inptr(24);
    const bf16* GVp = (const bf16*)(F.ws + WS_GV); bf16* ACTp = (bf16*)(F.ws + WS_ACT);
    {
        const float* halo = (const float*)(F.ws + WS_GV);
        for (long i = gtid; i < (long)128 * 2 * CH; i += gthreads) {
            const int pm = (int)(i / (2 * CH)), rem = (int)(i - (long)pm * 2 * CH), ur = rem / CH, j0 = (rem - ur * CH) * 8;
            if ((pm & 15) == 0) continue;
            float g0[8], g1[8], g2[8], vl[8], w0[8], w1[8], w2[8], cb[8];
            const float* HLp = halo + ((size_t)(pm - 1) * 2) * DFF + j0; const float* HGp = halo + ((size_t)(128 + pm) * 2) * DFF + j0; const float* HVp = halo + ((size_t)(256 + pm) * 2) * DFF + j0;
            if (ur == 0) { ld8f(HLp, g0); ld8f(HLp + DFF, g1); ld8f(HGp, g2); ld8f(HVp, vl); } else { ld8f(HLp + DFF, g0); ld8f(HGp, g1); ld8f(HGp + DFF, g2); ld8f(HVp + DFF, vl); }
            ld8f(cw_ + j0, w0); ld8f(cw_ + DFF + j0, w1); ld8f(cw_ + 2 * DFF + j0, w2); ld8f(cbp_ + j0, cb);
            conv_row(g0, g1, g2, vl, w0, w1, w2, cb, ACTp + ((size_t)pm * 256 + ur) * DFF + j0);
        }
    }
    for (long i = gtid; i < (long)NS * CH; i += gthreads) {
        const int n = (int)(i / CH), j0 = (int)(i - (long)n * CH) * 8, r = MP + n;
        float g0[8], g1[8], g2[8], vl[8], w0[8], w1[8], w2[8], cb[8];
        unpack8(*(const v4u*)(GVp + (size_t)r * UPN + j0), g2); unpack8(*(const v4u*)(GVp + (size_t)r * UPN + DFF + j0), vl);
        ld8f(stc_ + ((size_t)n * 2 + 0) * DFF + j0, g0); ld8f(stc_ + ((size_t)n * 2 + 1) * DFF + j0, g1);
        ld8f(cw_ + j0, w0); ld8f(cw_ + DFF + j0, w1); ld8f(cw_ + 2 * DFF + j0, w2); ld8f(cbp_ + j0, cb);
        conv_row(g0, g1, g2, vl, w0, w1, w2, cb, ACTp + (size_t)r * DFF + j0);
        float* so = F.out + O_SCV + ((size_t)n * 2 + 1) * DFF + j0; *(f32x4*)so = (f32x4){g2[0], g2[1], g2[2], g2[3]}; *(f32x4*)(so + 4) = (f32x4){g2[4], g2[5], g2[6], g2[7]};
    }
}
__device__ __forceinline__ void p11_final(Frame& F) {
    const int gw = F.vcu * NWAVES + F.wave, NGW = F.G * NWAVES, lane = FLANE;
    const float* gf_ = inptr(26);
    f32x4 g[4];
#pragma unroll
    for (int j = 0; j < 4; ++j) g[j] = ((const f32x4*)gf_)[lane + 64 * j];
    const bf16* X3 = (const bf16*)(F.ws + WS_XN);
    for (int r0 = gw; r0 < MT; r0 += 4 * NGW) {
        u32x2v v[4][4]; float tot[4];
#pragma unroll
        for (int k = 0; k < 4; ++k) { const int r = r0 + k * NGW < MT ? r0 + k * NGW : MT - 1;
            tot[k] = lane < 16 ? ((float*)(F.ws + WS_SSQ3))[(size_t)r * 16 + lane] : 0.f;
#pragma unroll
            for (int j = 0; j < 4; ++j) v[k][j] = ((const u32x2v*)(X3 + (size_t)r * D))[lane + 64 * j]; }
#pragma unroll
        for (int k = 0; k < 4; ++k) { const int r = r0 + k * NGW < MT ? r0 + k * NGW : MT - 1;
            const float rstd = 1.0f / sqrtf(wave_sum(tot[k]) * (1.0f / D) + EPS);
            f32x4* yr = (f32x4*)(F.out + (size_t)r * D) + lane;
#pragma unroll
            for (int j = 0; j < 4; ++j) { const f32x4 x = (f32x4){bflo(v[k][j].x), bfhi(v[k][j].x), bflo(v[k][j].y), bfhi(v[k][j].y)}; __builtin_nontemporal_store(x * rstd * g[j], yr + 64 * j); } }
    }
}

template <class E>
__device__ __forceinline__ void sgemm(Frame& F, const bf16* X  , const bf16* Bt  , int N, int K, const E& e) {
    const int lane = FLANE, fr = lane & 15, fq = lane >> 4, items = 8 * (N / 16), nks = K / 32;
    for (int it = F.wave * F.G + F.vcu; it < items; it += NWAVES * F.G) {
        const int tt = it & 7, ct = it >> 3, n = tt * 16 + fr;
        const bf16* xp = X + (size_t)n * K + fq * 8;
        const bf16* wp = Bt + (size_t)(ct * 16 + fr) * K + fq * 8;
        f32x4 acc = (f32x4){0.f, 0.f, 0.f, 0.f};
#pragma unroll 16
        for (int ks = 0; ks < nks; ++ks) acc = __builtin_amdgcn_mfma_f32_16x16x32_bf16(*(const bf16x8*)(wp + ks * 32), *(const bf16x8*)(xp + ks * 32), acc, 0, 0, 0);
        float carry = 0.f;
        e.tile(n, ct * 16 + 4 * fq, acc, carry);
        e.finish(n, fq, carry);
    }
}
struct SEpiInProj {
    bf16* Z; float* out;
    __device__ __forceinline__ void tile(int n, int c0, const f32x4 v, float&) const {
        bf16* zrow = Z + (size_t)(MP + n) * ZP;
        const bool is_v = (c0 >= 1024 && c0 < 1536) || c0 >= 2176;
        if (is_v) {
            u32x2v w; w.x = pg8::cvt_pk_bf16(v[0], v[1]); w.y = pg8::cvt_pk_bf16(v[2], v[3]); *(u32x2v*)(zrow + c0) = w;
            float* so = (c0 < 2048) ? out + O_SAV + ((size_t)n * LA + (LA - 1)) * 512 + (c0 - 1024) : out + O_SBV + ((size_t)n * LB + (LB - 1)) * 128 + (c0 - 2176);
            *(f32x4*)so = v;
        } else {
            const int hb = c0 & ~63, d = (c0 & 63) >> 1;
            float o1[2], o2[2];
#pragma unroll
            for (int i = 0; i < 2; ++i) { float rev = 16384.0f * (__builtin_amdgcn_exp2f(-(float)(d + i) * (13.287712379549449f / 32.0f)) * 0.15915494309189535f); rev -= __builtin_floorf(rev);
                const float cs = __builtin_amdgcn_cosf(rev), sn = __builtin_amdgcn_sinf(rev), x1 = v[2 * i], x2 = v[2 * i + 1]; o1[i] = x1 * cs - x2 * sn; o2[i] = x2 * cs + x1 * sn; }
            const bool is_q = (c0 < 512) || (c0 >= 1536 && c0 < 2048);
            if (is_q) { o1[0] *= QSCALE64; o1[1] *= QSCALE64; o2[0] *= QSCALE64; o2[1] *= QSCALE64; }
            *(unsigned*)(zrow + hb + d) = pg8::cvt_pk_bf16(o1[0], o1[1]); *(unsigned*)(zrow + hb + 32 + d) = pg8::cvt_pk_bf16(o2[0], o2[1]);
            if (!is_q) {
                float* so = (c0 < 2048) ? out + O_SAK + ((size_t)n * LA + (LA - 1)) * 512 + (hb - 512) + d : out + O_SBK + ((size_t)n * LB + (LB - 1)) * 128 + (hb - 2048) + d;
                typedef float f32x2s __attribute__((ext_vector_type(2)));
                *(f32x2s*)so = (f32x2s){o1[0], o1[1]}; *(f32x2s*)(so + 32) = (f32x2s){o2[0], o2[1]};
            }
        }
    }
    __device__ __forceinline__ void finish(int, int, float) const {}
};
template <bool FIRST> struct SEpiResid {
    const float* xs; bf16* xb; float* ssq;
    __device__ __forceinline__ void tile(int n, int c0, f32x4 v, float& carry) const {
        const size_t r = (size_t)(MP + n);
        if (FIRST) v = v + *(const f32x4*)(xs + (size_t)n * D + c0);
        else { const u32x2v x = *(const u32x2v*)(xb + r * D + c0); v[0] += bflo(x.x); v[1] += bfhi(x.x); v[2] += bflo(x.y); v[3] += bfhi(x.y); }
        carry += (v[0] * v[0] + v[1] * v[1]) + (v[2] * v[2] + v[3] * v[3]);
        u32x2v w; w.x = pg8::cvt_pk_bf16(v[0], v[1]); w.y = pg8::cvt_pk_bf16(v[2], v[3]); *(u32x2v*)(xb + r * D + c0) = w;
    }
    __device__ __forceinline__ void finish(int n, int fq, float carry) const {
        carry += __shfl_xor(carry, 16); carry += __shfl_xor(carry, 32);
        if (fq == 0) atomicAdd(ssq + (size_t)(MP + n) * 16, carry);
    }
};
struct SEpiScale {
    bf16* O; int ldc; const float* ssq; float scale; int up_perm;
    __device__ __forceinline__ void tile(int n, int c0, const f32x4 v, float&) const {
        const size_t r = (size_t)(MP + n);
        const f32x4 s0 = *(const f32x4*)(ssq + r * 16), s1 = *(const f32x4*)(ssq + r * 16 + 4), s2 = *(const f32x4*)(ssq + r * 16 + 8), s3 = *(const f32x4*)(ssq + r * 16 + 12);
        const f32x4 st = (s0 + s1) + (s2 + s3); const float sc = __builtin_amdgcn_rsqf(((st[0] + st[1]) + (st[2] + st[3])) * (1.0f / D) + EPS) * scale;
        const int col = up_perm ? ((c0 & 128) ? DFF : 0) + (c0 >> 8) * 128 + (c0 & 127) : c0;
        u32x2v w; w.x = pg8::cvt_pk_bf16(v[0] * sc, v[1] * sc); w.y = pg8::cvt_pk_bf16(v[2] * sc, v[3] * sc); *(u32x2v*)(O + r * ldc + col) = w;
    }
    __device__ __forceinline__ void finish(int, int, float) const {}
};
struct Args { const float* in[27]; float* out; unsigned char* ws; int ph_lo, ph_hi; };
__global__ void __launch_bounds__(NWAVES * 64, 2) fwd(Args args) {
    extern __shared__ __attribute__((aligned(16))) unsigned char lds[];
    Frame F;
    F.lds = (LAS unsigned char*)lds;
    F.MISC = (volatile LAS unsigned*)(F.lds + MISC_OFF);
    F.wave = __builtin_amdgcn_readfirstlane((int)threadIdx.x >> 6);
    F.G = gridDim.x; { const int bx = blockIdx.x; F.vcu = (F.G % 8 == 0) ? (bx % 8) * (F.G / 8) + bx / 8 : bx; }
    F.ws = args.ws; F.out = args.out; F.ctl = (gu32*)(F.ws + WS_CTL);
    for (int u = FTID; u < (LDS_BYTES - LDSCTL_OFF) / 4; u += NWAVES * 64) ((LAS unsigned*)(F.lds + LDSCTL_OFF))[u] = 0u;
    __syncthreads();
    XcdBarrier bar; bar.bar = (unsigned*)(F.ctl + CW_BAR); bar.x = 0; bar.st = nullptr;
    if (N_LAUNCHES == 1) bar = xcd_barrier_post((unsigned*)(F.ctl + CW_BAR), F.MISC + 8);
    const int lo = args.ph_lo, hi = args.ph_hi;
#define IN(k) (lo <= (k) && (k) < hi)
#define SEAM(k) do { if (IN(k) && IN((k) + 1)) xcd_barrier(bar); } while (0)
    typedef pg8::bf16_t pb;
#define MKCOPY(j0_, quota_) pg8::KCopy{(const char*)inptr(2), (const char*)inptr(3), (char*)(F.out + O_SAK), (char*)(F.out + O_SAV), (j0_), (quota_), F.vcu * NWAVES + F.wave, F.G * NWAVES, (unsigned)COPY_OFF, 0, 1}
#define MKCOPY2(j0_, quota_, xj0_, xquota_) pg8::KCopy2{(const char*)inptr(2), (const char*)inptr(3), (char*)(F.out + O_SAK), (char*)(F.out + O_SAV), (j0_), (quota_), F.vcu * NWAVES + F.wave, F.G * NWAVES, (unsigned)COPY_OFF, (xj0_), (xquota_)}
    if (IN(0)) { p0_prologue(F); }
    SEAM(0);
    if (IN(1)) {
        { SEpiInProj e{((bf16*)(F.ws + WS_Z)), F.out}; sgemm(F, ((bf16*)(F.ws + WS_XN)) + (size_t)MP * D, ((bf16*)(F.ws + WS_WIN)), ZP, D, e); }
        { pg8::Gemm g{(const pb*)((bf16*)(F.ws + WS_XN)), (const pb*)((bf16*)(F.ws + WS_WIN)), MP, ZP, D}; pg8::StaticOrder So; So.init(MP, ZP, F.G, (int)blockIdx.x);
          pg8::EpiInProj E{(pb*)((bf16*)(F.ws + WS_Z)), F.out};
          pg8::gemm_phase<pg8::EpiInProj, pg8::StaticOrder, true, true, pg8::KCopy>(F.lds, g, So, E, MKCOPY(0, 64)); }
        { pg8::Gemm g{(const pb*)((bf16*)(F.ws + WS_MEMN)), (const pb*)((bf16*)(F.ws + WS_WMKV)), NB * MEMT, 2048, D}; pg8::StaticOrder So; So.init(NB * MEMT, 2048, F.G, (int)((blockIdx.x + F.G - (128 % F.G)) % F.G));
          pg8::EpiMemKV E{(pb*)((bf16*)(F.ws + WS_MK)), (pb*)((bf16*)(F.ws + WS_MV)), F.out};
          pg8::gemm_phase<pg8::EpiMemKV, pg8::StaticOrder, true, true>(F.lds, g, So, E); }
    }
    SEAM(1);
    if (IN(2)) { p2_attention(F); }
    SEAM(2);
    if (IN(3)) { p3_mix(F); }
    SEAM(3);
    if (IN(4)) {
        { SEpiResid<true> e{inptr(1), ((bf16*)(F.ws + WS_XN)), ((float*)(F.ws + WS_SSQ1))}; sgemm(F, ((bf16*)(F.ws + WS_OC)) + (size_t)MP * D, ((bf16*)(F.ws + WS_WOUT)), D, D, e); }
        pg8::Gemm g{(const pb*)((bf16*)(F.ws + WS_OC)), (const pb*)((bf16*)(F.ws + WS_WOUT)), MP, D, D}; pg8::StaticOrder So; So.init(MP, D, F.G, (int)blockIdx.x);
        pg8::EpiResid<true> E{inptr(0), (pb*)((bf16*)(F.ws + WS_XN)), ((float*)(F.ws + WS_SSQ1))};
        pg8::gemm_phase<pg8::EpiResid<true>, pg8::StaticOrder, true, true, pg8::KCopy>(F.lds, g, So, E, MKCOPY(64, 32));
    }
    SEAM(4);
    if (IN(5)) {
        { SEpiScale e{((bf16*)(F.ws + WS_QX)), D, ((float*)(F.ws + WS_SSQ1)), QSCALE256, 0}; sgemm(F, ((bf16*)(F.ws + WS_XN)) + (size_t)MP * D, ((bf16*)(F.ws + WS_WXQ)), D, D, e); }
        pg8::Gemm g{(const pb*)((bf16*)(F.ws + WS_XN)), (const pb*)((bf16*)(F.ws + WS_WXQ)), MP, D, D}; pg8::StaticOrder So; So.init(MP, D, F.G, (int)blockIdx.x);
        pg8::EpiScaleBf16 E{(pb*)((bf16*)(F.ws + WS_QX)), D, ((float*)(F.ws + WS_SSQ1)), QSCALE256};
        pg8::gemm_phase<pg8::EpiScaleBf16, pg8::StaticOrder, true, true, pg8::KCopy>(F.lds, g, So, E, MKCOPY(96, 32));
    }
    SEAM(5);
    if (IN(6)) { p6_cross(F); }
    SEAM(6);
    if (IN(7)) {
        { SEpiResid<false> e{nullptr, ((bf16*)(F.ws + WS_XN)), ((float*)(F.ws + WS_SSQ2))}; sgemm(F, ((bf16*)(F.ws + WS_OX)) + (size_t)MP * D, ((bf16*)(F.ws + WS_WXO)), D, D, e); }
        pg8::Gemm g{(const pb*)((bf16*)(F.ws + WS_OX)), (const pb*)((bf16*)(F.ws + WS_WXO)), MP, D, D}; pg8::StaticOrder So; So.init(MP, D, F.G, (int)blockIdx.x);
        pg8::EpiResid<false> E{nullptr, (pb*)((bf16*)(F.ws + WS_XN)), ((float*)(F.ws + WS_SSQ2))};
        pg8::gemm_phase<pg8::EpiResid<false>, pg8::StaticOrder, true, true, pg8::KCopy>(F.lds, g, So, E, MKCOPY(128, 32));
    }
    SEAM(7);
    if (IN(8)) {
        { SEpiScale e{((bf16*)(F.ws + WS_GV)), UPN, ((float*)(F.ws + WS_SSQ2)), 1.0f, 1}; sgemm(F, ((bf16*)(F.ws + WS_XN)) + (size_t)MP * D, ((bf16*)(F.ws + WS_WUP)), UPN, D, e); }
        pg8::Gemm g{(const pb*)((bf16*)(F.ws + WS_XN)), (const pb*)((bf16*)(F.ws + WS_WUP)), MP, UPN, D}; pg8::StaticOrder So; So.init(MP, UPN, F.G, (int)blockIdx.x);
        pg8::EpiConvFfn E{(pb*)((bf16*)(F.ws + WS_ACT)), ((float*)(F.ws + WS_SSQ2)), inptr(23), inptr(24), F.out, (float*)(F.ws + WS_GV), (LAS float*)(F.lds + EXCH_OFF)};
        pg8::gemm_phase<pg8::EpiConvFfn, pg8::StaticOrder, true, true, pg8::KCopy>(F.lds, g, So, E, MKCOPY(160, 176));
    }
    SEAM(8);
    if (IN(9)) { p9_conv(F); }
    SEAM(9);
    if (IN(10)) {
        { SEpiResid<false> e{nullptr, ((bf16*)(F.ws + WS_XN)), ((float*)(F.ws + WS_SSQ3))}; sgemm(F, ((bf16*)(F.ws + WS_ACT)) + (size_t)MP * DFF, ((bf16*)(F.ws + WS_WDN)), D, DFF, e); }
        pg8::Gemm g{(const pb*)((bf16*)(F.ws + WS_ACT)), (const pb*)((bf16*)(F.ws + WS_WDN)), MP, D, DFF}; pg8::StaticOrder So; So.init(MP, D, F.G, (int)blockIdx.x);
        pg8::EpiResid<false> E{nullptr, (pb*)((bf16*)(F.ws + WS_XN)), ((float*)(F.ws + WS_SSQ3))};
        pg8::gemm_phase<pg8::EpiResid<false>, pg8::StaticOrder, true, true, pg8::KCopy2>(F.lds, g, So, E, MKCOPY2(336, 88, 424, 44));
    }
    SEAM(10);
    if (IN(11)) { p11_final(F); }
#undef IN
#undef SEAM
}

extern "C" void kernel_launch(void* const* d_in, const int* in_sizes, int n_in, void* d_out, int out_size, void* d_ws, size_t ws_size, hipStream_t stream) {
    static int grid = 0;
    if (grid == 0) {
        if (n_in != 27 || (size_t)out_size != O_END || ws_size < WS_END) { fprintf(stderr, "kernel_launch: unexpected shapes: n_in %d out %d ws %zu\n", n_in, out_size, ws_size); grid = -1; return; }
        int dev = 0, cus = 0, per_cu = 0;
        if (hipGetDevice(&dev) != hipSuccess || hipDeviceGetAttribute(&cus, hipDeviceAttributeMultiprocessorCount, dev) != hipSuccess) { grid = -1; return; }
        if (hipFuncSetAttribute((const void*)fwd, hipFuncAttributeMaxDynamicSharedMemorySize, LDS_BYTES) != hipSuccess) { fprintf(stderr, "kernel_launch: hipFuncSetAttribute failed\n"); grid = -1; return; }
        if (hipOccupancyMaxActiveBlocksPerMultiprocessor(&per_cu, (const void*)fwd, NWAVES * 64, LDS_BYTES) != hipSuccess || per_cu < 1) fprintf(stderr, "kernel_launch: occupancy query reports %d\n", per_cu);
        (void)hipGetLastError();
        grid = cus;
    }
    if (grid < 0) return;
    (void)hipMemsetAsync((char*)d_ws + WS_CTL, 0, CTL_ZERO_BYTES, stream);
    Args a{};
    for (int i = 0; i < 27; ++i) a.in[i] = (const float*)d_in[i];
    a.out = (float*)d_out; a.ws = (unsigned char*)d_ws;
    if (N_LAUNCHES == 1) { a.ph_lo = 0; a.ph_hi = NPH; hipLaunchKernelGGL(fwd, dim3(grid), dim3(NWAVES * 64), LDS_BYTES, stream, a); }
    else for (int p = 0; p < NPH; ++p) { a.ph_lo = p; a.ph_hi = p + 1; hipLaunchKernelGGL(fwd, dim3(grid), dim3(NWAVES * 64), LDS_BYTES, stream, a); }
}
```

```cpp
#include <hip/hip_runtime.h>
#include <cstdio>
#include <cstdint>
namespace pg8 {
#define PG8_LAS __attribute__((address_space(3)))
typedef unsigned short bf16_t;
typedef short bf16x8 __attribute__((ext_vector_type(8)));
typedef float f32x4 __attribute__((ext_vector_type(4)));
typedef unsigned u32x4 __attribute__((ext_vector_type(4)));
constexpr int BM = 256, BK = 64, HALF = 128, HTB = HALF * BK * 2  , STAGE_BYTES = 8 * HTB, NXCD = 8, WGM = 8;

__host__ __device__ __forceinline__ int lds_byte(int r, int c) { const int st = (r >> 4) * 2 + (c >> 5), rr = r & 15, cc = c & 31, ob = rr * 64 + cc * 2; return st * 1024 + (ob ^ (((ob >> 9) & 1) << 5)); }
__host__ __device__ __forceinline__ void stage_rc(int b, int& R, int& C) { const int st = b / 1024, sb = b % 1024, swz = sb ^ (((sb >> 9) & 1) << 5); R = (st >> 1) * 16 + swz / 64; C = (st & 1) * 32 + (swz % 64) / 2; }
__host__ __device__ __forceinline__ int perm32(int rho) { const int n = rho >> 4, i = rho & 15; return 8 * (i >> 2) + 4 * n + (i & 3); }

struct Unit { int pm, pn; };
struct Gemm { const bf16_t* A; const bf16_t* Bt; int M, N, K; };

struct StaticOrder {
    int nM, nN, nwg, G, c;
    __host__ __device__ void init(int M, int N, int G_, int c_) { nM = M / BM; nN = N / BM; nwg = nM * nN; G = G_; c = c_; }
    __host__ __device__ bool next(int i, Unit& u) const {
        const long L = (long)i * G + c; if (L >= nwg) return false;
        int wgid = (int)L; { const int q = nwg / NXCD, r = nwg % NXCD, xcd = wgid % NXCD, off = wgid / NXCD; wgid = (xcd < r ? xcd * (q + 1) : r * (q + 1) + (xcd - r) * q) + off; }
        const int nig = WGM * nN, gid = wgid / nig, fm = gid * WGM, gsz = (nM - fm) < WGM ? (nM - fm) : WGM;
        u.pm = fm + ((wgid % nig) % gsz); u.pn = (wgid % nig) / gsz; return true;
    }
    __device__ __forceinline__ void a_ready(const Unit&) const {}
    __device__ __forceinline__ void done(const Unit&) const {}
};

__device__ __forceinline__ unsigned cvt_pk_bf16(float lo, float hi) { unsigned r; asm volatile("v_cvt_pk_bf16_f32 %0, %1, %2" : "=v"(r) : "v"(lo), "v"(hi)); return r; }
typedef float f32x2 __attribute__((ext_vector_type(2)));
typedef unsigned u32x2 __attribute__((ext_vector_type(2)));
namespace shp {
constexpr int D = 1024, NB = 8, S = 4096, MP = NB * S, NS = 128, MT = MP + NS, MPAD = 33024;
constexpr int ZP = 2304, DFF = 2816, UPN = 5632, LA = 2048, LB = 128, MEMT = 256;
constexpr float LOG2E = 1.4426950408889634f;
constexpr float QSCALE64 = 0.125f * LOG2E, QSCALE256 = 0.0625f * LOG2E, EPS = 1e-6f;
constexpr size_t O_YP = 0;
constexpr size_t O_YS = O_YP + (size_t)MP * D;
constexpr size_t O_PAK = O_YS + (size_t)NS * D;
constexpr size_t O_PAV = O_PAK + (size_t)NB * LA * 512;
constexpr size_t O_PBK = O_PAV + (size_t)NB * LA * 512;
constexpr size_t O_PBV = O_PBK + (size_t)NB * LB * 128;
constexpr size_t O_PMK = O_PBV + (size_t)NB * LB * 128;
constexpr size_t O_PMV = O_PMK + (size_t)NB * MEMT * 1024;
constexpr size_t O_PCV = O_PMV + (size_t)NB * MEMT * 1024;
constexpr size_t O_SAK = O_PCV + (size_t)NB * 2 * DFF;
constexpr size_t O_SAV = O_SAK + (size_t)NS * LA * 512;
constexpr size_t O_SBK = O_SAV + (size_t)NS * LA * 512;
constexpr size_t O_SBV = O_SBK + (size_t)NS * LB * 128;
constexpr size_t O_SCV = O_SBV + (size_t)NS * LB * 128;
constexpr size_t O_END = O_SCV + (size_t)NS * 2 * DFF;
}
struct EpiInProj {
    static constexpr bool PERM = true, AFTER_DRAIN = false;
    bf16_t* Z; float* out;
    __device__ __forceinline__ void operator()(const f32x4 (&acc)[2][2][4][2], const Unit& u, int wr, int wc, int fr, int fq) const {
        using namespace shp;
        const int ct = u.pn * BM;
        int fqo = fq; asm volatile("" : "+v"(fqo));
        const int d0 = 16 * (wc & 1) + 4 * fqo;
        float inv[4];
#pragma unroll
        for (int i = 0; i < 4; ++i) inv[i] = __builtin_amdgcn_exp2f(-(float)(d0 + i) * (13.287712379549449f / 32.0f)) * 0.15915494309189535f;
#pragma unroll
        for (int ai = 0; ai < 2; ++ai)
#pragma unroll
            for (int m = 0; m < 4; ++m) {
                const int r = u.pm * BM + ai * HALF + wr * 64 + m * 16 + fr;
                const bool prompt = r < MP, sample = (r >= MP) && (r < MT);
                const int t = r & (S - 1), b = r >> 12, n = r - MP;
                const float pos = prompt ? (float)t : 16384.0f;
                float cs[4], sn[4];
#pragma unroll
                for (int i = 0; i < 4; ++i) { float rev = pos * inv[i]; rev -= __builtin_floorf(rev); cs[i] = __builtin_amdgcn_cosf(rev); sn[i] = __builtin_amdgcn_sinf(rev); }
                bf16_t* zrow = Z + (size_t)r * ZP;
#pragma unroll
                for (int bj = 0; bj < 2; ++bj) {
                    const int cb = ct + bj * HALF + wc * 32 + 8 * fq;
                    const int hb = cb & ~63;
                    const f32x4 a0 = acc[ai][bj][m][0], a1 = acc[ai][bj][m][1];
                    const bool is_v = (ct == 1024) || (ct == 1280) || (ct == 2048 && bj == 1);
                    if (is_v) {
                        u32x4 w; w.x = cvt_pk_bf16(a0[0], a0[1]); w.y = cvt_pk_bf16(a0[2], a0[3]); w.z = cvt_pk_bf16(a1[0], a1[1]); w.w = cvt_pk_bf16(a1[2], a1[3]);
                        *(u32x4*)(zrow + cb) = w;
                        float* so = nullptr;
                        if (ct < 2048) { const int c = cb - 1024;
                            if (prompt && t >= S - LA) so = out + O_PAV + ((size_t)b * LA + (t - (S - LA))) * 512 + c;
                            else if (sample) so = out + O_SAV + ((size_t)n * LA + (LA - 1)) * 512 + c;
                        } else { const int c = cb - 2176;
                            if (prompt && t >= S - LB) so = out + O_PBV + ((size_t)b * LB + (t - (S - LB))) * 128 + c;
                            else if (sample) so = out + O_SBV + ((size_t)n * LB + (LB - 1)) * 128 + c;
                        }
                        if (so) { __builtin_nontemporal_store(a0, (f32x4*)so); __builtin_nontemporal_store(a1, (f32x4*)(so + 4)); }
                    } else {
                        const bool is_q = (ct < 512) || (ct >= 1536 && ct < 2048);
                        const float x1[4] = {a0[0], a0[2], a1[0], a1[2]}, x2[4] = {a0[1], a0[3], a1[1], a1[3]};
                        float o1[4], o2[4];
#pragma unroll
                        for (int i = 0; i < 4; ++i) { o1[i] = x1[i] * cs[i] - x2[i] * sn[i]; o2[i] = x2[i] * cs[i] + x1[i] * sn[i]; }
                        if (is_q) {
#pragma unroll
                            for (int i = 0; i < 4; ++i) { o1[i] *= QSCALE64; o2[i] *= QSCALE64; }
                        }
                        u32x2 lo, hi; lo.x = cvt_pk_bf16(o1[0], o1[1]); lo.y = cvt_pk_bf16(o1[2], o1[3]); hi.x = cvt_pk_bf16(o2[0], o2[1]); hi.y = cvt_pk_bf16(o2[2], o2[3]);
                        *(u32x2*)(zrow + hb + d0) = lo; *(u32x2*)(zrow + hb + 32 + d0) = hi;
                        if (!is_q) {
                            float* so = nullptr;
                            if (ct < 2048) { const int c = hb - 512 + d0;
                                if (prompt && t >= S - LA) so = out + O_PAK + ((size_t)b * LA + (t - (S - LA))) * 512 + c;
                                else if (sample) so = out + O_SAK + ((size_t)n * LA + (LA - 1)) * 512 + c;
                            } else { const int c = hb - 2048 + d0;
                                if (prompt && t >= S - LB) so = out + O_PBK + ((size_t)b * LB + (t - (S - LB))) * 128 + c;
                                else if (sample) so = out + O_SBK + ((size_t)n * LB + (LB - 1)) * 128 + c;
                            }
                            if (so) { __builtin_nontemporal_store((f32x4){o1[0], o1[1], o1[2], o1[3]}, (f32x4*)so); __builtin_nontemporal_store((f32x4){o2[0], o2[1], o2[2], o2[3]}, (f32x4*)(so + 32)); }
                        }
                    }
                }
            }
    }
};
struct EpiMemKV {
    static constexpr bool PERM = true, AFTER_DRAIN = false;
    bf16_t* MK; bf16_t* MV; float* out;
    __device__ __forceinline__ void operator()(const f32x4 (&acc)[2][2][4][2], const Unit& u, int wr, int wc, int fr, int fq) const {
        using namespace shp;
        const bool isv = u.pn >= 4; const int ct = (u.pn & 3) * BM;
        bf16_t* B = isv ? MV : MK; float* O = out + (isv ? O_PMV : O_PMK);
#pragma unroll
        for (int ai = 0; ai < 2; ++ai)
#pragma unroll
            for (int m = 0; m < 4; ++m) { const size_t r = (size_t)(u.pm * BM + ai * HALF + wr * 64 + m * 16 + fr);
#pragma unroll
                for (int bj = 0; bj < 2; ++bj) { const int c = ct + bj * HALF + wc * 32 + 8 * fq; const f32x4 a0 = acc[ai][bj][m][0], a1 = acc[ai][bj][m][1];
                    u32x4 w; w.x = cvt_pk_bf16(a0[0], a0[1]); w.y = cvt_pk_bf16(a0[2], a0[3]); w.z = cvt_pk_bf16(a1[0], a1[1]); w.w = cvt_pk_bf16(a1[2], a1[3]);
                    *(u32x4*)(B + r * 1024 + c) = w; __builtin_nontemporal_store(a0, (f32x4*)(O + r * 1024 + c)); __builtin_nontemporal_store(a1, (f32x4*)(O + r * 1024 + c + 4)); } }
    }
};
template <bool FIRST> struct EpiResid {
    static constexpr bool PERM = false, AFTER_DRAIN = false;
    const float* xp;
    bf16_t* xb; float* ssq;
    __device__ __forceinline__ void operator()(const f32x4 (&acc)[2][2][4][2], const Unit& u, int wr, int wc, int fr, int fq) const {
        using namespace shp;
#pragma unroll
        for (int ai = 0; ai < 2; ++ai)
#pragma unroll
            for (int m = 0; m < 4; ++m) { const size_t r = (size_t)(u.pm * BM + ai * HALF + wr * 64 + m * 16 + fr);
                float q = 0.f;
#pragma unroll
                for (int bj = 0; bj < 2; ++bj)
#pragma unroll
                    for (int n = 0; n < 2; ++n) { const int c = u.pn * BM + bj * HALF + wc * 32 + n * 16 + 4 * fq;
                        f32x4 v = acc[ai][bj][m][n];
                        if (FIRST) v = v + __builtin_nontemporal_load((const f32x4*)(xp + r * D + c));
                        else { const u32x2 x = *(const u32x2*)(xb + r * D + c); v[0] += __builtin_bit_cast(float, x.x << 16); v[1] += __builtin_bit_cast(float, x.x & 0xffff0000u); v[2] += __builtin_bit_cast(float, x.y << 16); v[3] += __builtin_bit_cast(float, x.y & 0xffff0000u); }
                        q += (v[0] * v[0] + v[1] * v[1]) + (v[2] * v[2] + v[3] * v[3]);
                        u32x2 w; w.x = cvt_pk_bf16(v[0], v[1]); w.y = cvt_pk_bf16(v[2], v[3]); *(u32x2*)(xb + r * D + c) = w; }
                q += __shfl_xor(q, 16); q += __shfl_xor(q, 32);
                if (fq == 0) ssq[r * 16 + u.pn * 4 + wc] = q; }
    }
};
struct EpiScaleBf16 {
    static constexpr bool PERM = true, AFTER_DRAIN = false;
    bf16_t* O; int ldc; const float* ssq; float scale;
    __device__ __forceinline__ void operator()(const f32x4 (&acc)[2][2][4][2], const Unit& u, int wr, int wc, int fr, int fq) const {
        using namespace shp;
#pragma unroll
        for (int ai = 0; ai < 2; ++ai)
#pragma unroll
            for (int m = 0; m < 4; ++m) { const size_t r = (size_t)(u.pm * BM + ai * HALF + wr * 64 + m * 16 + fr);
                const f32x4 s0 = *(const f32x4*)(ssq + r * 16), s1 = *(const f32x4*)(ssq + r * 16 + 4), s2 = *(const f32x4*)(ssq + r * 16 + 8), s3 = *(const f32x4*)(ssq + r * 16 + 12);
                const f32x4 st = (s0 + s1) + (s2 + s3); const float tot = (st[0] + st[1]) + (st[2] + st[3]);
                const float sc = __builtin_amdgcn_rsqf(tot * (1.0f / D) + EPS) * scale;
#pragma unroll
                for (int bj = 0; bj < 2; ++bj) { const int c = u.pn * BM + bj * HALF + wc * 32 + 8 * fq; const f32x4 a0 = acc[ai][bj][m][0] * sc, a1 = acc[ai][bj][m][1] * sc;
                    u32x4 w; w.x = cvt_pk_bf16(a0[0], a0[1]); w.y = cvt_pk_bf16(a0[2], a0[3]); w.z = cvt_pk_bf16(a1[0], a1[1]); w.w = cvt_pk_bf16(a1[2], a1[3]);
                    *(u32x4*)(O + r * ldc + c) = w; } }
    }
};

template <int CTRL> __device__ __forceinline__ float dpp_mov(float old, float src) {
    return __builtin_bit_cast(float, __builtin_amdgcn_update_dpp(__builtin_bit_cast(int, old), __builtin_bit_cast(int, src), CTRL, 0xf, 0xf, false));
}
struct EpiConvFfn {
    static constexpr bool PERM = true, AFTER_DRAIN = false;
    bf16_t* ACT; const float* ssq; const float* cw; const float* cb; float* out; float* halo; PG8_LAS float* ex;
    __device__ __forceinline__ float row_rstd(size_t r) const {
        using namespace shp;
        const f32x4 s0 = *(const f32x4*)(ssq + r * 16), s1 = *(const f32x4*)(ssq + r * 16 + 4), s2 = *(const f32x4*)(ssq + r * 16 + 8), s3 = *(const f32x4*)(ssq + r * 16 + 12);
        const f32x4 st = (s0 + s1) + (s2 + s3); return __builtin_amdgcn_rsqf(((st[0] + st[1]) + (st[2] + st[3])) * (1.0f / D) + EPS);
    }
    __device__ __forceinline__ void operator()(const f32x4 (&acc)[2][2][4][2], const Unit& u, int wr, int wc, int fr_in, int fq_in) const {
        using namespace shp;
        int fr = fr_in, fq = fq_in; asm volatile("" : "+v"(fr), "+v"(fq));
        const int j0 = u.pn * 128 + wc * 32 + 8 * fq;
        PG8_LAS float* rsb = ex + 1024;
        { int tid_ = (int)threadIdx.x; asm volatile("" : "+v"(tid_));
          if (tid_ < 256) rsb[tid_] = row_rstd((size_t)(u.pm * BM + tid_)); }
        asm volatile("s_waitcnt lgkmcnt(0)" ::: "memory"); __builtin_amdgcn_s_barrier(); asm volatile("" ::: "memory");
#pragma unroll
        for (int ai = 0; ai < 2; ++ai) { const float sc = rsb[ai * HALF + wr * 64 + 48 + fr];
            if (fr >= 14) { PG8_LAS float* e = ex + ((((ai * 2 + wr) * 4 + wc) * 2 + (fr - 14)) * 4 + fq) * 8;
                *(PG8_LAS f32x4*)e = acc[ai][0][3][0] * sc; *(PG8_LAS f32x4*)(e + 4) = acc[ai][0][3][1] * sc; } }
        asm volatile("s_waitcnt lgkmcnt(0)" ::: "memory"); __builtin_amdgcn_s_barrier(); asm volatile("" ::: "memory");
        float w0[8], w1[8], w2[8], cbv[8];
        { const f32x4 a0 = *(const f32x4*)(cw + j0), a1 = *(const f32x4*)(cw + j0 + 4), b0 = *(const f32x4*)(cw + DFF + j0), b1 = *(const f32x4*)(cw + DFF + j0 + 4),
                      c0 = *(const f32x4*)(cw + 2 * DFF + j0), c1 = *(const f32x4*)(cw + 2 * DFF + j0 + 4), d0 = *(const f32x4*)(cb + j0), d1 = *(const f32x4*)(cb + j0 + 4);
#pragma unroll
          for (int i = 0; i < 4; ++i) { w0[i] = a0[i]; w0[4 + i] = a1[i]; w1[i] = b0[i]; w1[4 + i] = b1[i]; w2[i] = c0[i]; w2[4 + i] = c1[i]; cbv[i] = d0[i]; cbv[4 + i] = d1[i]; } }
        const bool first_panel = (u.pm & 15) == 0;
#pragma unroll
        for (int ai = 0; ai < 2; ++ai) {
            float prev[8];
#pragma unroll
            for (int i = 0; i < 8; ++i) prev[i] = 0.f;
            const bool has_pred = (wr == 1) || (ai == 1);
            if (has_pred && fr >= 14) { const int pa = (wr == 1) ? ai : 0, pw = (wr == 1) ? 0 : 1;
                const PG8_LAS float* ep = ex + ((((pa * 2 + pw) * 4 + wc) * 2 + (fr - 14)) * 4 + fq) * 8;
                const f32x4 e0 = *(const PG8_LAS f32x4*)ep, e1 = *(const PG8_LAS f32x4*)(ep + 4);
#pragma unroll
                for (int i = 0; i < 4; ++i) { prev[i] = e0[i]; prev[4 + i] = e1[i]; } }
#pragma unroll
            for (int m = 0; m < 4; ++m) {
                const int ur = ai * HALF + wr * 64 + m * 16 + fr; const size_t r = (size_t)u.pm * BM + ur;
                const float sc = rsb[ur];
                float x[8], vv[8], a[8];
#pragma unroll
                for (int i = 0; i < 4; ++i) { x[i] = acc[ai][0][m][0][i] * sc; x[4 + i] = acc[ai][0][m][1][i] * sc; vv[i] = acc[ai][1][m][0][i] * sc; vv[4 + i] = acc[ai][1][m][1][i] * sc; }
#pragma unroll
                for (int i = 0; i < 8; ++i) {
                    const float p1 = dpp_mov<0x111>(dpp_mov<0x121>(prev[i], prev[i]), x[i]), p2 = dpp_mov<0x112>(dpp_mov<0x122>(prev[i], prev[i]), x[i]);
                    const float c = cbv[i] + w0[i] * p2 + w1[i] * p1 + w2[i] * x[i];
                    a[i] = c * __builtin_amdgcn_rcpf(1.0f + __builtin_amdgcn_exp2f(-c * LOG2E)) * vv[i]; }
                const bool halo_row = (!first_panel) && (ur < 2);
                if (!halo_row) { u32x4 w; w.x = cvt_pk_bf16(a[0], a[1]); w.y = cvt_pk_bf16(a[2], a[3]); w.z = cvt_pk_bf16(a[4], a[5]); w.w = cvt_pk_bf16(a[6], a[7]); *(u32x4*)(ACT + r * DFF + j0) = w; }
                else { float* hg = halo + ((size_t)(128 + u.pm) * 2 + ur) * DFF + j0; float* hv = halo + ((size_t)(256 + u.pm) * 2 + ur) * DFF + j0;
                    *(f32x4*)hg = (f32x4){x[0], x[1], x[2], x[3]}; *(f32x4*)(hg + 4) = (f32x4){x[4], x[5], x[6], x[7]};
                    *(f32x4*)hv = (f32x4){vv[0], vv[1], vv[2], vv[3]}; *(f32x4*)(hv + 4) = (f32x4){vv[4], vv[5], vv[6], vv[7]}; }
                if (ur >= 254) { float* hl = halo + ((size_t)u.pm * 2 + (ur - 254)) * DFF + j0;
                    *(f32x4*)hl = (f32x4){x[0], x[1], x[2], x[3]}; *(f32x4*)(hl + 4) = (f32x4){x[4], x[5], x[6], x[7]};
                    if ((u.pm & 15) == 15) { float* pc = out + O_PCV + ((size_t)(u.pm >> 4) * 2 + (ur - 254)) * DFF + j0;
                        *(f32x4*)pc = (f32x4){x[0], x[1], x[2], x[3]}; *(f32x4*)(pc + 4) = (f32x4){x[4], x[5], x[6], x[7]}; } }
#pragma unroll
                for (int i = 0; i < 8; ++i) prev[i] = x[i];
                asm volatile("" ::: "memory");
            }
        }
    }
};
struct NoCopy { static constexpr bool ON = false, X2 = false; unsigned ldsoff; __device__ __forceinline__ void addr(int, const char*&, char*&) const {} __device__ __forceinline__ void xaddr(int, const char*&, char*&) const {} };
template <bool X2_> struct KCopyT {
    static constexpr bool ON = true, X2 = X2_;
    const char* src0; const char* src1; char* dst0; char* dst1; int j0, quota, gw, ngw; unsigned ldsoff; int xj0, xquota;
    __device__ __forceinline__ void xaddr(int j, const char*& s, char*& d) const { const int jj = j < xquota ? j : xquota - 1; addr_id((unsigned)(xj0 + jj) * (unsigned)ngw + (unsigned)gw, s, d); }
    __device__ __forceinline__ void addr(int j, const char*& s, char*& d) const { const int jj = j < quota ? j : quota - 1; addr_id((unsigned)(j0 + jj) * (unsigned)ngw + (unsigned)gw, s, d); }
    __device__ __forceinline__ void addr_id(unsigned cid_in, const char*& s, char*& d) const {
        const unsigned cid = cid_in < 1048064u ? cid_in : 1048063u;
        const bool t1 = cid >= 524032u; const unsigned rem = t1 ? cid - 524032u : cid, n = rem / 4094u, off = rem - n * 4094u;
        const size_t so = (size_t)n * 4194304u + 2048u + (size_t)off * 1024u, dof = (size_t)n * 4194304u + (size_t)off * 1024u;
        s = (t1 ? src1 : src0) + so; d = (t1 ? dst1 : dst0) + dof;
    }
};
typedef KCopyT<false> KCopy; typedef KCopyT<true> KCopy2;
template <class Epi, class Sched, bool ALIGN_EPI = false, bool SP2 = false, class Cp = NoCopy>
__device__ __forceinline__ void gemm_phase(PG8_LAS unsigned char* lds, const Gemm g, const Sched& S, const Epi& E, const Cp C = Cp()) {
    static_assert(!Cp::ON || SP2, "the copy rider is written for the SP2 loop");
    int cl = 0;
#define PG8_CLOAD(slot) do { if constexpr (Cp::ON) { const char* s_; char* d_; C.addr(cl, s_, d_); __builtin_amdgcn_global_load_lds((const unsigned*)(s_ + lane * 16), (PG8_LAS unsigned*)(lds + C.ldsoff + wid * 2048 + (slot) * 1024), 16, 0, 2); ++cl; } } while (0)
#define PG8_CREAD(slot, v_) do { if constexpr (Cp::ON) { v_ = *(const PG8_LAS u32x4*)(lds + C.ldsoff + wid * 2048 + (slot) * 1024 + lane * 16); } } while (0)
#define PG8_CSTORE(idx, v_) do { if constexpr (Cp::ON) { const char* s_; char* d_; C.addr((idx), s_, d_); const int o_ = lane * 16; asm volatile("global_store_dwordx4 %0, %1, %2 nt\n\ts_nop 1" :: "v"(o_), "v"(v_), "s"(d_) : "memory"); } } while (0)
#define PG8_WAIT_VC(nx2) do { if constexpr (Cp::X2) { PG8_WAIT_V(nx2); } else if constexpr (Cp::ON) { PG8_WAIT_V(10); } else { PG8_WAIT_V(8); } } while (0)
#define PG8_CLOAD2() do { if constexpr (Cp::X2) { const char* s_; char* d_; C.xaddr(cx, s_, d_); __builtin_amdgcn_global_load_lds((const unsigned*)(s_ + lane * 16), (PG8_LAS unsigned*)(lds + C.ldsoff + 16384 + wid * 1024), 16, 0, 2); ++cx; } } while (0)
#define PG8_CSTORE2(v_) do { if constexpr (Cp::X2) { const char* s_; char* d_; C.xaddr(cx - 1, s_, d_); const int o_ = lane * 16; asm volatile("global_store_dwordx4 %0, %1, %2 nt\n\ts_nop 1" :: "v"(o_), "v"(v_), "s"(d_) : "memory"); } } while (0)
#define PG8_CREAD2(v_) do { if constexpr (Cp::X2) { v_ = *(const PG8_LAS u32x4*)(lds + C.ldsoff + 16384 + wid * 1024 + lane * 16); } } while (0)
    int cx = 0;
    u32x4 cv = (u32x4){0u, 0u, 0u, 0u};
    const int tid = threadIdx.x, wid = __builtin_amdgcn_readfirstlane(tid >> 6), lane = tid & 63, wr = wid >> 2, wc = wid & 3, fr = lane & 15, fq = lane >> 4;
    const int K = g.K, nt = K / BK;
    unsigned voffA[2], voffB[2];
#pragma unroll
    for (int i = 0; i < 2; ++i) { int R, C; stage_rc(tid * 16 + i * 8192, R, C); const int Rb = Epi::PERM ? ((R & ~31) + perm32(R & 31)) : R;
        voffA[i] = (unsigned)(R * K + C) * 2u; voffB[i] = (unsigned)(Rb * K + C) * 2u; }
    const size_t kstep = (size_t)(BK * 2);
    const size_t hstep = (size_t)HALF * K * 2;
    const size_t tstep = 2 * hstep;
    const unsigned ldsw = (unsigned)wid * 1024u;
    const int aoff = lds_byte(wr * 64 + fr, fq * 8), boff = lds_byte(wc * 32 + fr, fq * 8);
#define PG8_SA(b, h) (((b) * 2 + (h)) * HTB)
#define PG8_SB(b, h) ((4 + (b) * 2 + (h)) * HTB)
#define PG8_STAGE(bufoff, gbase, voff) do { _Pragma("unroll") for (int _i = 0; _i < 2; ++_i) \
        __builtin_amdgcn_global_load_lds((const unsigned*)((const char*)(gbase) + (voff)[_i]), (PG8_LAS unsigned*)(lds + (bufoff) + ldsw + _i * 8192), 16, 0, 0); } while (0)
#define PG8_LDA(dst, b, h) do { _Pragma("unroll") for (int m = 0; m < 4; ++m) _Pragma("unroll") for (int k = 0; k < 2; ++k) dst[m][k] = *(const PG8_LAS bf16x8*)(lds + PG8_SA(b, h) + aoff + m * 2048 + k * 1024); } while (0)
#define PG8_LDB(dst, b, h) do { _Pragma("unroll") for (int n = 0; n < 2; ++n) _Pragma("unroll") for (int k = 0; k < 2; ++k) dst[n][k] = *(const PG8_LAS bf16x8*)(lds + PG8_SB(b, h) + boff + n * 2048 + k * 1024); } while (0)
#define PG8_MMA(ai, bj, At, Bt) do { __builtin_amdgcn_s_setprio(1); _Pragma("unroll") for (int m = 0; m < 4; ++m) _Pragma("unroll") for (int n = 0; n < 2; ++n) _Pragma("unroll") for (int k = 0; k < 2; ++k) \
        acc[ai][bj][m][n] = __builtin_amdgcn_mfma_f32_16x16x32_bf16(Bt[n][k], At[m][k], acc[ai][bj][m][n], 0, 0, 0); __builtin_amdgcn_s_setprio(0); } while (0)
#define PG8_WAIT_V(n) asm volatile("s_waitcnt vmcnt(" #n ")" ::: "memory")
#define PG8_WAIT_L(n) asm volatile("s_waitcnt lgkmcnt(" #n ")" ::: "memory")
#define PG8_BAR __builtin_amdgcn_s_barrier()
#define PG8_SCHED __builtin_amdgcn_sched_barrier(0)
    Unit cur, nxt; int ui = 0;
    if (!S.next(0, cur)) return;
    f32x4 acc[2][2][4][2];
#pragma unroll
    for (int a = 0; a < 2; ++a)
#pragma unroll
        for (int b = 0; b < 2; ++b)
#pragma unroll
            for (int m = 0; m < 4; ++m)
#pragma unroll
                for (int n = 0; n < 2; ++n) acc[a][b][m][n] = (f32x4){0.f, 0.f, 0.f, 0.f};
    bf16x8 At[4][2], B0[2][2], B1[2][2];
    const char* cA = (const char*)g.A + (size_t)cur.pm * tstep; const char* cB = (const char*)g.Bt + (size_t)cur.pn * tstep;
    S.a_ready(cur);
    if constexpr (SP2) {
        PG8_STAGE(PG8_SB(0, 0), cB, voffB); PG8_STAGE(PG8_SB(0, 1), cB + hstep, voffB); PG8_STAGE(PG8_SA(0, 0), cA, voffA); PG8_STAGE(PG8_SA(0, 1), cA + hstep, voffA);
        if (wr == 1) PG8_BAR;
        PG8_WAIT_V(2); PG8_BAR;
        PG8_CLOAD(1);
        PG8_STAGE(PG8_SB(1, 0), cB + kstep, voffB); PG8_STAGE(PG8_SA(1, 0), cA + kstep, voffA); PG8_STAGE(PG8_SB(1, 1), cB + hstep + kstep, voffB);
        PG8_WAIT_V(6); PG8_BAR;
    } else {
        PG8_STAGE(PG8_SB(0, 0), cB, voffB); PG8_STAGE(PG8_SA(0, 0), cA, voffA); PG8_STAGE(PG8_SB(0, 1), cB + hstep, voffB); PG8_STAGE(PG8_SA(0, 1), cA + hstep, voffA);
        if (wr == 1) PG8_BAR;
        PG8_WAIT_V(4); PG8_BAR;
        PG8_STAGE(PG8_SB(1, 0), cB + kstep, voffB); PG8_STAGE(PG8_SA(1, 0), cA + kstep, voffA); PG8_STAGE(PG8_SB(1, 1), cB + hstep + kstep, voffB);
        PG8_WAIT_V(6); PG8_BAR;
    }
    for (;;) {
        const bool has_next = S.next(ui + 1, nxt);
        const char* nA = has_next ? (const char*)g.A + (size_t)nxt.pm * tstep : cA; const char* nB = has_next ? (const char*)g.Bt + (size_t)nxt.pn * tstep : cB;
        for (int t = 0; t < nt; t += 2) {
            const bool last = (t == nt - 2);
            const char* a1 = cA + (size_t)(t + 1) * kstep;
            const char* a2 = last ? nA : cA + (size_t)(t + 2) * kstep; const char* b2 = last ? nB : cB + (size_t)(t + 2) * kstep;
            const char* a3 = a2 + kstep; const char* b3 = b2 + kstep;
            if (last && has_next) S.a_ready(nxt);
            if constexpr (SP2) {
            PG8_LDB(B0, 0, 0); PG8_LDB(B1, 0, 1); PG8_SCHED; PG8_LDA(At, 0, 0); PG8_CLOAD(0); PG8_CLOAD2(); PG8_STAGE(PG8_SA(1, 1), a1 + hstep, voffA);
            PG8_WAIT_VC(12); PG8_WAIT_L(0); PG8_BAR; PG8_MMA(0, 0, At, B0); PG8_MMA(0, 1, At, B1); PG8_BAR; PG8_SCHED;
            PG8_LDA(At, 0, 1); PG8_STAGE(PG8_SB(0, 0), b2, voffB); PG8_STAGE(PG8_SB(0, 1), b2 + hstep, voffB); PG8_STAGE(PG8_SA(0, 0), a2, voffA); PG8_CREAD(1, cv); PG8_CSTORE(cl - 2, cv);
            PG8_WAIT_VC(11); PG8_WAIT_L(0); PG8_BAR; PG8_MMA(1, 0, At, B0); PG8_MMA(1, 1, At, B1); PG8_BAR; PG8_SCHED;
            PG8_LDB(B0, 1, 0); PG8_LDB(B1, 1, 1); PG8_SCHED; PG8_LDA(At, 1, 0); PG8_CLOAD(1); PG8_STAGE(PG8_SA(0, 1), a2 + hstep, voffA);
            PG8_WAIT_VC(10); PG8_WAIT_L(0); PG8_BAR; PG8_MMA(0, 0, At, B0); PG8_MMA(0, 1, At, B1); PG8_BAR; PG8_SCHED;
            PG8_LDA(At, 1, 1); PG8_STAGE(PG8_SB(1, 0), b3, voffB); PG8_STAGE(PG8_SB(1, 1), b3 + hstep, voffB); PG8_STAGE(PG8_SA(1, 0), a3, voffA); PG8_CREAD(0, cv); PG8_CSTORE(cl - 2, cv); PG8_CREAD2(cv); PG8_CSTORE2(cv);
            PG8_WAIT_VC(11); PG8_WAIT_L(0); PG8_BAR; PG8_MMA(1, 0, At, B0); PG8_MMA(1, 1, At, B1); PG8_BAR; PG8_SCHED;
            } else {
            PG8_LDB(B0, 0, 0); PG8_SCHED; PG8_LDA(At, 0, 0); PG8_STAGE(PG8_SA(1, 1), a1 + hstep, voffA);
            PG8_WAIT_L(8); PG8_BAR; PG8_WAIT_L(0); PG8_MMA(0, 0, At, B0); PG8_BAR; PG8_SCHED;
            PG8_LDB(B1, 0, 1); PG8_STAGE(PG8_SB(0, 0), b2, voffB);
            PG8_BAR; PG8_WAIT_L(0); PG8_MMA(0, 1, At, B1); PG8_BAR;
            PG8_LDA(At, 0, 1); PG8_STAGE(PG8_SA(0, 0), a2, voffA);
            PG8_BAR; PG8_WAIT_L(0); PG8_MMA(1, 0, At, B0); PG8_BAR; PG8_SCHED;
            PG8_STAGE(PG8_SB(0, 1), b2 + hstep, voffB);
            PG8_WAIT_V(6); PG8_BAR; PG8_MMA(1, 1, At, B1); PG8_BAR;
            PG8_LDB(B0, 1, 0); PG8_SCHED; PG8_LDA(At, 1, 0); PG8_STAGE(PG8_SA(0, 1), a2 + hstep, voffA);
            PG8_WAIT_L(8); PG8_BAR; PG8_WAIT_L(0); PG8_MMA(0, 0, At, B0); PG8_BAR; PG8_SCHED;
            PG8_LDB(B1, 1, 1); PG8_STAGE(PG8_SB(1, 0), b3, voffB);
            PG8_BAR; PG8_WAIT_L(0); PG8_MMA(0, 1, At, B1); PG8_BAR;
            PG8_LDA(At, 1, 1); PG8_STAGE(PG8_SA(1, 0), a3, voffA);
            PG8_BAR; PG8_WAIT_L(0); PG8_MMA(1, 0, At, B0); PG8_BAR; PG8_SCHED;
            PG8_STAGE(PG8_SB(1, 1), b3 + hstep, voffB);
            PG8_WAIT_V(6); PG8_BAR; PG8_MMA(1, 1, At, B1); PG8_BAR;
            }
        }
        if constexpr (ALIGN_EPI) { if (wr == 0) PG8_BAR; }
        if constexpr (!Epi::AFTER_DRAIN) { E(acc, cur, wr, wc, fr, fq); S.done(cur); }
        if (!has_next) break;
#pragma unroll
        for (int a = 0; a < 2; ++a)
#pragma unroll
            for (int b = 0; b < 2; ++b)
#pragma unroll
                for (int m = 0; m < 4; ++m)
#pragma unroll
                    for (int n = 0; n < 2; ++n) acc[a][b][m][n] = (f32x4){0.f, 0.f, 0.f, 0.f};
        cur = nxt; cA = nA; cB = nB; ++ui;
        if constexpr (ALIGN_EPI) { if (wr == 1) PG8_BAR; }
    }
    PG8_WAIT_V(0);
    if constexpr (!ALIGN_EPI) { if (wr == 0) PG8_BAR; }
    PG8_BAR;
    PG8_CREAD(1, cv); PG8_CSTORE(cl - 1, cv);
    if constexpr (Epi::AFTER_DRAIN) { E.fused(acc, cur, wr, wc, fr, fq, lds, wid, lane); S.done(cur); }
#undef PG8_CLOAD
#undef PG8_CREAD
#undef PG8_CSTORE
#undef PG8_WAIT_VC
#undef PG8_CLOAD2
#undef PG8_CSTORE2
#undef PG8_CREAD2
#undef PG8_SA
#undef PG8_SB
#undef PG8_STAGE
#undef PG8_LDA
#undef PG8_LDB
#undef PG8_MMA
#undef PG8_WAIT_V
#undef PG8_WAIT_L
#undef PG8_BAR
#undef PG8_SCHED
}
}
#define GAS __attribute__((address_space(1)))
#define LAS __attribute__((address_space(3)))
typedef unsigned short bf16;
typedef unsigned v4u __attribute__((ext_vector_type(4)));
typedef float f32x4 __attribute__((ext_vector_type(4)));
typedef short bf16x8 __attribute__((ext_vector_type(8)));
typedef GAS unsigned gu32;
typedef GAS unsigned long long gu64;
#define RLX_AGENT __ATOMIC_RELAXED, __HIP_MEMORY_SCOPE_AGENT
#define LDS_WAIT() asm volatile("s_waitcnt lgkmcnt(0)" ::: "memory")
#define VM_WAIT() asm volatile("s_waitcnt vmcnt(0)" ::: "memory")
__device__ __forceinline__ unsigned long long rt() { return __builtin_amdgcn_s_memrealtime(); }
__device__ __forceinline__ unsigned f2bf(float f) { unsigned u = __builtin_bit_cast(unsigned, f); return (u + 0x7fffu + ((u >> 16) & 1u)) >> 16; }
__device__ __forceinline__ unsigned pk2(float lo, float hi) { return f2bf(lo) | (f2bf(hi) << 16); }

#define XB_TMO      128
#define XB_XCNT(j)  (256  + 64 * (j))
#define XB_XSUB(j)  (1280 + 64 * (j))
#define XB_XGEN(j)  (2304 + 64 * (j))
#define XB_TOP      3328
#define XB_TOPGEN   3392
#define XCD_BAR_WORDS 3456
#define XB_SPIN_CAP (1u << 18)

__device__ __forceinline__ unsigned xb_ld(unsigned* p)              { return __hip_atomic_load(p, __ATOMIC_RELAXED, __HIP_MEMORY_SCOPE_AGENT); }
__device__ __forceinline__ unsigned xb_add(unsigned* p, unsigned v) { return __hip_atomic_fetch_add(p, v, __ATOMIC_RELAXED, __HIP_MEMORY_SCOPE_AGENT); }
__device__ __forceinline__ unsigned xb_xcc_id() { return (unsigned)__builtin_amdgcn_s_getreg((3 << 11) | 20) & 0xFu; }
#define XB_SPIN(cond, bar) do { unsigned _sp = 0; while (cond) { __builtin_amdgcn_s_sleep(1); \
    if ((++_sp & 255u) == 0u) { if (xb_ld(&(bar)[XB_TMO])) break; if (_sp > XB_SPIN_CAP) { atomicAdd(&(bar)[XB_TMO], 1u); break; } } } } while (0)

struct XcdBarrier {
    unsigned* bar; unsigned x;
    volatile LAS unsigned* st;
};

__device__ __forceinline__ XcdBarrier xcd_barrier_post(unsigned* bar, volatile LAS unsigned* st) {
    XcdBarrier b; b.bar = bar; b.x = xb_xcc_id(); b.st = st;
    if (threadIdx.x == 0) (void)xb_add(&bar[XB_XCNT(b.x)], 1u);
    return b;
}
__device__ __forceinline__ void xcd_barrier_complete(unsigned* bar, unsigned x, unsigned& nloc, unsigned& nx) {
    const unsigned G = gridDim.x * gridDim.y * gridDim.z;
    unsigned sum, cnt, mine, sp = 0u;
    for (;;) {
        sum = 0u; cnt = 0u; mine = 0u;
#pragma unroll
        for (unsigned j = 0; j < 16; ++j) { const unsigned c = xb_ld(&bar[XB_XCNT(j)]); sum += c; cnt += (c > 0u) ? 1u : 0u; mine = (j == x) ? c : mine; }
        if (sum == G) break;
        __builtin_amdgcn_s_sleep(1);
        if ((++sp & 255u) == 0u) { if (xb_ld(&bar[XB_TMO])) break; if (sp > XB_SPIN_CAP) { atomicAdd(&bar[XB_TMO], 1u); break; } }
    }
    nloc = mine > 0u ? mine : 1u; nx = cnt > 0u ? cnt : 1u;
}

__device__ __forceinline__ void xcd_barrier(const XcdBarrier& b) {
    asm volatile("s_waitcnt vmcnt(0)" ::: "memory");
    __syncthreads();
    if (threadIdx.x == 0) {
        unsigned* bar = b.bar;
        __builtin_amdgcn_s_waitcnt(0);
        unsigned nloc = b.st[0], nx = b.st[1];
        if (nloc == 0u) { xcd_barrier_complete(bar, b.x, nloc, nx); b.st[0] = nloc; b.st[1] = nx; }
        const unsigned old = xb_add(&bar[XB_XSUB(b.x)], 1u);
        const unsigned gen = old / nloc;
        if (old + 1u == (gen + 1u) * nloc) {
            __builtin_amdgcn_fence(__ATOMIC_RELEASE, "agent");
            asm volatile("s_waitcnt vmcnt(0)" ::: "memory");
            const unsigned og = xb_add(&bar[XB_TOP], 1u);
            const unsigned tg = og / nx;
            if (og + 1u == (tg + 1u) * nx) xb_add(&bar[XB_TOPGEN], 1u);
            else XB_SPIN(xb_ld(&bar[XB_TOPGEN]) == tg, bar);
            __builtin_amdgcn_fence(__ATOMIC_ACQUIRE, "agent");
            xb_add(&bar[XB_XGEN(b.x)], 1u);
            asm volatile("s_waitcnt vmcnt(0)" ::: "memory");
        } else {
            XB_SPIN(xb_ld(&bar[XB_XGEN(b.x)]) == gen, bar);
            __builtin_amdgcn_fence(__ATOMIC_ACQUIRE, "agent");
            asm volatile("s_waitcnt vmcnt(0)" ::: "memory");
        }
    }
    __syncthreads();
}
using namespace pg8::shp;
constexpr int NWAVES = 8;
#ifndef MK_N_LAUNCHES
#define MK_N_LAUNCHES 1
#endif
constexpr int NPH = 12;
constexpr int N_LAUNCHES = MK_N_LAUNCHES;
constexpr size_t MiB = 1u << 20;
constexpr size_t WS_CTL = 0, CTL_ZERO_BYTES = 1 * MiB;
constexpr size_t WS_WIN = 2 * MiB, WS_WOUT = 7 * MiB, WS_WXQ = 9 * MiB, WS_WMKV = 11 * MiB, WS_WXO = 15 * MiB, WS_WUP = 17 * MiB, WS_WDN = 28 * MiB;
constexpr size_t WS_MEMN = 34 * MiB, WS_MK = 38 * MiB, WS_MV = 42 * MiB, WS_SSQ1 = 46 * MiB, WS_SSQ2 = 49 * MiB, WS_SSQ3 = 52 * MiB, WS_SO = 55 * MiB, WS_PL = 56 * MiB;
constexpr size_t WS_XN = 64 * MiB, WS_Z = 130 * MiB, WS_PO = 276 * MiB, WS_OB = 372 * MiB, WS_OC = 404 * MiB, WS_XRES = 470 * MiB, WS_QX = 600 * MiB, WS_OX = 665 * MiB;
constexpr size_t WS_GV = 730 * MiB, WS_ACT = 1085 * MiB, WS_END = 1264 * MiB;
constexpr int CW_BAR = 4096;
constexpr int RING_BYTES = 131072, LDSCTL_OFF = RING_BYTES, MISC_OFF = LDSCTL_OFF + 320, COPY_OFF = RING_BYTES + 1024, EXCH_OFF = COPY_OFF + 16384 + 8192, LDS_BYTES = EXCH_OFF + 4096 + 1024;
constexpr int RIDER_CHUNKS = 468;
constexpr unsigned COPY_CHUNKS = 2u * 524032u;

typedef float f32x16 __attribute__((ext_vector_type(16)));
typedef short s16x4 __attribute__((ext_vector_type(4)));
typedef short v4i16_t __attribute__((ext_vector_type(4)));
typedef unsigned u32x2v __attribute__((ext_vector_type(2)));
constexpr int SWA_NU_HOST = 3 * 2048 + 512;
__device__ __forceinline__ int fresh_tid() { int t = (int)threadIdx.x; asm volatile("" : "+v"(t)); return t; }
#define FTID (fresh_tid())
#define FLANE (fresh_tid() & 63)
__device__ __forceinline__ const float* inptr(int i) {
    const __attribute__((address_space(4))) char* ka = (const __attribute__((address_space(4))) char*)__builtin_amdgcn_kernarg_segment_ptr();
    int off = i * 8; asm volatile("" : "+s"(off));
    return *(const float* const __attribute__((address_space(4)))*)(ka + off);
}
struct Frame {
    LAS unsigned char* lds;
    volatile LAS unsigned* MISC;
    gu32* ctl;
    int wave, vcu, G;
    float* out; unsigned char* ws;
};
__device__ __forceinline__ float wave_sum(float v) {
#pragma unroll
    for (int o = 1; o < 64; o <<= 1) v += __shfl_xor(v, o);
    return v;
}
__device__ __forceinline__ float bf2f(unsigned short h) { return __builtin_bit_cast(float, (unsigned)h << 16); }
__device__ __forceinline__ float bflo(unsigned w) { return __builtin_bit_cast(float, w << 16); }
__device__ __forceinline__ float bfhi(unsigned w) { return __builtin_bit_cast(float, w & 0xffff0000u); }
__device__ __forceinline__ int crow(int r, int hi) { return (r & 3) + 8 * (r >> 2) + 4 * hi; }
__device__ __forceinline__ s16x4 vtr(LAS const unsigned char* p) { return __builtin_bit_cast(s16x4, __builtin_amdgcn_ds_read_tr16_b64_v4i16((LAS v4i16_t*)p)); }
#define VTRA(dst, addr, OFF) asm volatile("ds_read_b64_tr_b16 %0, %1 offset:%c2" : "=&v"(dst) : "v"(addr), "i"(OFF) : "memory")
#define LGKM0() do { asm volatile("s_waitcnt lgkmcnt(0)" ::: "memory"); __builtin_amdgcn_sched_barrier(0); } while (0)
__device__ __forceinline__ unsigned lds_addr(LAS const unsigned char* p) { return (unsigned)(uintptr_t)p; }

constexpr float NEGBIG = -1.0e30f;

__device__ __forceinline__ int drow_of(int n, int mode) {
    if (mode == 1 && (n < 1024 || (n >= 1536 && n < 2176))) { const int dd = n & 63; return (n & ~63) + (dd < 32 ? 2 * dd : 2 * (dd - 32) + 1); }
    if (mode == 2) { const int j = n < DFF ? n : n - DFF; return (j >> 7) * 256 + (n < DFF ? 0 : 128) + (j & 127); }
    return n;
}
__device__ __forceinline__ void p0_transpose_item(const float* W, int K, int N, bf16* WT, const float* ga, const float* gb, int gsplit, int mode, LAS float* scr, int item, int lane) {
    const int nblk = N / 32, kb = item / nblk, nb = item % nblk, k0 = 64 * kb, n0 = 32 * nb;
    float wv_[32];
#pragma unroll
    for (int i = 0; i < 32; ++i) wv_[i] = __builtin_nontemporal_load(W + (size_t)(k0 + 2 * i + (lane >> 5)) * N + n0 + (lane & 31));
#pragma unroll
    for (int i = 0; i < 32; ++i) { const int kk = 2 * i + (lane >> 5); const int k = k0 + kk;
        float g = 1.0f; if (ga) g = (k < gsplit) ? ga[k] : gb[k - gsplit];
        scr[kk * 33 + (lane & 31)] = wv_[i] * g; }
    LDS_WAIT(); asm volatile("" ::: "memory");
    const int c = lane & 7;
#pragma unroll
    for (int j = 0; j < 4; ++j) { const int n = (lane >> 3) + 8 * j; const LAS float* s = scr + (8 * c) * 33 + n;
        v4u o; o.x = pk2(s[0 * 33], s[1 * 33]); o.y = pk2(s[2 * 33], s[3 * 33]); o.z = pk2(s[4 * 33], s[5 * 33]); o.w = pk2(s[6 * 33], s[7 * 33]);
        *(GAS v4u*)(WT + (size_t)drow_of(n0 + n, mode) * K + k0 + 8 * c) = o; }
    LDS_WAIT(); asm volatile("" ::: "memory");
}
__device__ __forceinline__ void rms_rows4_to_bf16(int lane, const float* const (&xrow)[4], bf16* const (&orow)[4]) {
    f32x4 v[4][4];
#pragma unroll
    for (int q = 0; q < 4; ++q)
#pragma unroll
        for (int j = 0; j < 4; ++j) v[q][j] = __builtin_nontemporal_load((const f32x4*)xrow[q] + lane + 64 * j);
#pragma unroll
    for (int q = 0; q < 4; ++q) { float s = 0.f;
#pragma unroll
        for (int j = 0; j < 4; ++j) s += (v[q][j].x * v[q][j].x + v[q][j].y * v[q][j].y) + (v[q][j].z * v[q][j].z + v[q][j].w * v[q][j].w);
        const float rstd = 1.f / sqrtf(wave_sum(s) * (1.f / D) + EPS);
        GAS unsigned long long* o8 = (GAS unsigned long long*)orow[q] + lane;
#pragma unroll
        for (int j = 0; j < 4; ++j) o8[64 * j] = (unsigned long long)pk2(v[q][j].x * rstd, v[q][j].y * rstd) | ((unsigned long long)pk2(v[q][j].z * rstd, v[q][j].w * rstd) << 32); }
}
__device__ __forceinline__ void copy_shift(const float* src, float* dst, int nb, int rows, int rowf, long gtid, long gthreads) {
    const long per = (long)(rows - 1) * rowf / 4, tot = per * nb;
    for (long i0 = gtid; i0 < tot; i0 += 4 * gthreads) {
        f32x4 v[4]; long o[4];
#pragma unroll
        for (int k = 0; k < 4; ++k) { const long i = i0 + k * gthreads; const long ic = i < tot ? i : tot - 1; const long n = ic / per, off = ic - n * per; o[k] = n * (long)rows * rowf / 4 + off;
            v[k] = __builtin_nontemporal_load((const f32x4*)(src + rowf) + o[k]); }
#pragma unroll
        for (int k = 0; k < 4; ++k) __builtin_nontemporal_store(v[k], (f32x4*)dst + o[k]);
    }
}
__device__ __forceinline__ void p0_prologue(Frame& F) {
    LAS float* scr = (LAS float*)(F.lds + F.wave * 16384);
    const int gw = F.vcu * NWAVES + F.wave, NGW = F.G * NWAVES;
    constexpr int I_IN = 16 * 72, I_OUT = 16 * 32, I_XQ = 16 * 32, I_MKV = 16 * 64, I_XO = 16 * 32, I_UP = 16 * 176, I_DN = 44 * 32;
    constexpr int NITEMS = I_IN + I_OUT + I_XQ + I_MKV + I_XO + I_UP + I_DN;
    for (int it = gw; it < NITEMS; it += NGW) {
        int r = it;
        if (r < I_IN) { p0_transpose_item(inptr(11), 1024, 2304, ((bf16*)(F.ws + WS_WIN)), inptr(10), inptr(10), 1024, 1, scr, r, FLANE); continue; } r -= I_IN;
        if (r < I_OUT) { p0_transpose_item(inptr(15), 1024, 1024, ((bf16*)(F.ws + WS_WOUT)), inptr(12), inptr(13), 512, 0, scr, r, FLANE); continue; } r -= I_OUT;
        if (r < I_XQ) { p0_transpose_item(inptr(18), 1024, 1024, ((bf16*)(F.ws + WS_WXQ)), inptr(16), inptr(16), 1024, 0, scr, r, FLANE); continue; } r -= I_XQ;
        if (r < I_MKV) { p0_transpose_item(inptr(19), 1024, 2048, ((bf16*)(F.ws + WS_WMKV)), inptr(17), inptr(17), 1024, 0, scr, r, FLANE); continue; } r -= I_MKV;
        if (r < I_XO) { p0_transpose_item(inptr(20), 1024, 1024, ((bf16*)(F.ws + WS_WXO)), nullptr, nullptr, 0, 0, scr, r, FLANE); continue; } r -= I_XO;
        if (r < I_UP) { p0_transpose_item(inptr(22), 1024, 5632, ((bf16*)(F.ws + WS_WUP)), inptr(21), inptr(21), 1024, 2, scr, r, FLANE); continue; } r -= I_UP;
        p0_transpose_item(inptr(25), 2816, 1024, ((bf16*)(F.ws + WS_WDN)), nullptr, nullptr, 0, 0, scr, r, FLANE);
    }
    const float* xp_ = inptr(0); const float* xs_ = inptr(1); const float* mp_ = inptr(9);
    constexpr int NROWS = MT + NB * MEMT;
    for (int m0 = gw; m0 < NROWS; m0 += 4 * NGW) {
        const float* xr[4]; bf16* orw[4];
#pragma unroll
        for (int q = 0; q < 4; ++q) { const int m = m0 + q * NGW < NROWS ? m0 + q * NGW : NROWS - 1;
            if (m < MP) { xr[q] = xp_ + (size_t)m * D; orw[q] = ((bf16*)(F.ws + WS_XN)) + (size_t)m * D; }
            else if (m < MT) { xr[q] = xs_ + (size_t)(m - MP) * D; orw[q] = ((bf16*)(F.ws + WS_XN)) + (size_t)m * D; }
            else { xr[q] = mp_ + (size_t)(m - MT) * D; orw[q] = ((bf16*)(F.ws + WS_MEMN)) + (size_t)(m - MT) * D; } }
        rms_rows4_to_bf16(FLANE, xr, orw);
    }
    const long gtid = (long)F.vcu * (NWAVES * 64) + FTID, gthreads = (long)F.G * (NWAVES * 64);
    if (gtid < NS * 16) { ((float*)(F.ws + WS_SSQ1))[(size_t)MP * 16 + gtid] = 0.f; ((float*)(F.ws + WS_SSQ2))[(size_t)MP * 16 + gtid] = 0.f; ((float*)(F.ws + WS_SSQ3))[(size_t)MP * 16 + gtid] = 0.f; }
    {
        const pg8::KCopy kc{(const char*)inptr(2), (const char*)inptr(3), (char*)(F.out + O_SAK), (char*)(F.out + O_SAV), 0, 1 << 30, 0, 1, 0u, 0, 1};
        const int ln = FLANE;
        for (unsigned c0 = (unsigned)(RIDER_CHUNKS + 2 * (SWA_NU_HOST / F.G)) * (unsigned)NGW + (unsigned)gw; c0 < COPY_CHUNKS; c0 += 16u * (unsigned)NGW) {
            f32x4 v[16]; char* dp[16];
#pragma unroll
            for (int k = 0; k < 16; ++k) { unsigned cid = c0 + (unsigned)k * (unsigned)NGW; cid = cid < COPY_CHUNKS ? cid : COPY_CHUNKS - 1u; const char* sp; kc.addr((int)cid, sp, dp[k]);
                v[k] = __builtin_nontemporal_load((const f32x4*)sp + ln); }
#pragma unroll
            for (int k = 0; k < 16; ++k) __builtin_nontemporal_store(v[k], (f32x4*)dp[k] + ln);
        }
    }
    copy_shift(inptr(4), F.out + O_SBK, NS, LB, 128, gtid, gthreads);
    copy_shift(inptr(5), F.out + O_SBV, NS, LB, 128, gtid, gthreads);
    copy_shift(inptr(8), F.out + O_SCV, NS, 2, DFF, gtid, gthreads);
}

struct SwaUnit { int kind, b, h, d, rho, i0; };
constexpr int SWA_NU = 3 * 2048 + 512;
__device__ __forceinline__ SwaUnit swa_decode(int U) {
    SwaUnit u;
    if (U >= 3 * 2048) { const int rem = U - 3 * 2048; u.kind = 3; u.b = rem >> 6; u.h = (rem >> 5) & 1; u.d = 1; u.rho = 0; u.i0 = (rem & 31) * 128; }
    else { u.kind = U >> 11; const int rem = U & 2047; u.b = rem >> 8; u.h = (rem >> 5) & 7; const int r5 = rem & 31;
        u.d = 1 << (2 * u.kind); const int nblk = 32 >> (2 * u.kind); u.rho = r5 / nblk; u.i0 = (r5 % nblk) * 128; }
    return u;
}
__device__ __forceinline__ void swa_stage(Frame& F, const SwaUnit& u, int buf, int lane) {
    const bool isB = u.kind == 3;
    const int kcol = isB ? 2048 + u.h * 64 : 512 + u.h * 64, vcol = isB ? 2176 + u.h * 64 : 1024 + u.h * 64;
    const bf16* Zb = ((bf16*)(F.ws + WS_Z)) + (size_t)u.b * S * ZP;
    LAS unsigned char* base = F.lds + buf * 65536;
#pragma unroll
    for (int i = 0; i < 4; ++i) {
        const int piece = F.wave * 4 + i, row = piece * 8 + (lane >> 3), cpos = lane & 7;
        int idx = u.i0 - 128 + row; idx = idx < 0 ? 0 : idx;
        const bf16* rp = Zb + (size_t)(u.rho + u.d * idx) * ZP;
        const int ck = cpos ^ (row & 7), cv = 2 * ((cpos >> 1) ^ ((row >> 1) & 3)) + (cpos & 1);
        __builtin_amdgcn_global_load_lds((const unsigned*)(rp + kcol + ck * 8), (LAS unsigned*)(base + piece * 1024), 16, 0, 0);
        __builtin_amdgcn_global_load_lds((const unsigned*)(rp + vcol + cv * 8), (LAS unsigned*)(base + 32768 + piece * 1024), 16, 0, 0);
    }
}
__device__ __forceinline__ void swa_compute(Frame& F, const SwaUnit& u, int buf, int lane, const bf16x8 (&qf)[2], float sinkv, int hq  ) {
    const int c = lane & 15, g = lane >> 4, w = F.wave;
    LAS const unsigned char* kb = F.lds + buf * 65536;
    LAS const unsigned char* vb = kb + 32768;
    f32x4 sc[9];
#pragma unroll
    for (int T = 0; T < 9; ++T) {
        const int row = 16 * (w + T) + c;
        f32x4 a = (f32x4){0.f, 0.f, 0.f, 0.f};
#pragma unroll
        for (int ks = 0; ks < 2; ++ks) { const bf16x8 kf = *(LAS const bf16x8*)(kb + row * 128 + (((ks * 4 + g) ^ (row & 7)) * 16));
            a = __builtin_amdgcn_mfma_f32_16x16x32_bf16(kf, qf[ks], a, 0, 0, 0); }
#pragma unroll
        for (int i = 0; i < 4; ++i) { const int diff = 128 + c - 16 * T - 4 * g - i; const int kidx = u.i0 - 128 + 16 * (w + T) + 4 * g + i;
            const bool valid = (diff >= 0) && (diff <= 128) && (kidx >= 0);
            a[i] = valid ? a[i] : NEGBIG; }
        sc[T] = a;
    }
    float m = NEGBIG;
#pragma unroll
    for (int T = 0; T < 9; ++T)
#pragma unroll
        for (int i = 0; i < 4; ++i) m = fmaxf(m, sc[T][i]);
    m = fmaxf(m, __shfl_xor(m, 16)); m = fmaxf(m, __shfl_xor(m, 32));
    float l = 0.f;
#pragma unroll
    for (int T = 0; T < 9; ++T)
#pragma unroll
        for (int i = 0; i < 4; ++i) { const float p = __builtin_amdgcn_exp2f(sc[T][i] - m); sc[T][i] = p; l += p; }
    l += __shfl_xor(l, 16); l += __shfl_xor(l, 32);
    bf16x8 pb[5];
#pragma unroll
    for (int j = 0; j < 5; ++j) { v4u wv;
        wv.x = pg8::cvt_pk_bf16(sc[2 * j][0], sc[2 * j][1]); wv.y = pg8::cvt_pk_bf16(sc[2 * j][2], sc[2 * j][3]);
        if (j < 4) { wv.z = pg8::cvt_pk_bf16(sc[2 * j + 1][0], sc[2 * j + 1][1]); wv.w = pg8::cvt_pk_bf16(sc[2 * j + 1][2], sc[2 * j + 1][3]); } else { wv.z = 0u; wv.w = 0u; }
        pb[j] = __builtin_bit_cast(bf16x8, wv); }
    f32x4 o[4];
#pragma unroll
    for (int dt = 0; dt < 4; ++dt) o[dt] = (f32x4){0.f, 0.f, 0.f, 0.f};
    {
        const int q = (lane & 15) >> 2, pp = lane & 3, rl = 4 * g + q;
        unsigned va[4];
#pragma unroll
        for (int dt = 0; dt < 4; ++dt) va[dt] = lds_addr(vb) + (unsigned)(2048 * w + rl * 128 + ((dt ^ ((rl >> 1) & 3)) * 32) + pp * 8);
        const s16x4 z4 = (s16x4){0, 0, 0, 0};
#define SWA_PV(j) do { s16x4 lo_[4], hh_[4]; \
        VTRA(lo_[0], va[0], (j) * 4096); VTRA(lo_[1], va[1], (j) * 4096); VTRA(lo_[2], va[2], (j) * 4096); VTRA(lo_[3], va[3], (j) * 4096); \
        if ((j) < 4) { VTRA(hh_[0], va[0], (j) * 4096 + 2048); VTRA(hh_[1], va[1], (j) * 4096 + 2048); VTRA(hh_[2], va[2], (j) * 4096 + 2048); VTRA(hh_[3], va[3], (j) * 4096 + 2048); } \
        else { hh_[0] = z4; hh_[1] = z4; hh_[2] = z4; hh_[3] = z4; } \
        LGKM0(); \
        _Pragma("unroll") for (int dt = 0; dt < 4; ++dt) { const bf16x8 vf = (bf16x8){lo_[dt][0], lo_[dt][1], lo_[dt][2], lo_[dt][3], hh_[dt][0], hh_[dt][1], hh_[dt][2], hh_[dt][3]}; \
            o[dt] = __builtin_amdgcn_mfma_f32_16x16x32_bf16(vf, pb[j], o[dt], 0, 0, 0); } } while (0)
        SWA_PV(0); SWA_PV(1); SWA_PV(2); SWA_PV(3); SWA_PV(4);
#undef SWA_PV
    }
    const bool isB = u.kind == 3;
    float linv = 1.0f / l; const float lse2 = m + __builtin_amdgcn_logf(l);
    if (isB) linv *= 1.0f / (1.0f + __builtin_amdgcn_exp2f(sinkv * LOG2E - lse2));
    const int tq = u.rho + u.d * (u.i0 + 16 * w + c);
    bf16* dst = (isB ? ((bf16*)(F.ws + WS_OB)) : ((bf16*)(F.ws + WS_PO)) + (size_t)u.kind * MP * 512) + ((size_t)u.b * S + tq) * 512 + hq * 64 + 4 * g;
#pragma unroll
    for (int dt = 0; dt < 4; ++dt) { u32x2v wv; wv.x = pg8::cvt_pk_bf16(o[dt][0] * linv, o[dt][1] * linv); wv.y = pg8::cvt_pk_bf16(o[dt][2] * linv, o[dt][3] * linv); *(u32x2v*)(dst + 16 * dt) = wv; }
    if (!isB && g == 0) ((float*)(F.ws + WS_PL))[(size_t)u.kind * MP * 8 + ((size_t)u.b * S + tq) * 8 + hq] = lse2;
}
__device__ __forceinline__ void swa_load_q(Frame& F, const SwaUnit& u, int lane, bf16x8 (&qf)[4][2], float (&sinkv)[4]) {
    const int c = lane & 15, g = lane >> 4; const bool isB = u.kind == 3;
    const bf16* qp = ((bf16*)(F.ws + WS_Z)) + ((size_t)u.b * S + u.rho + u.d * (u.i0 + 16 * F.wave + c)) * ZP + (isB ? 1536 + u.h * 256 : u.h * 64) + 8 * g;
    const float* sk = inptr(14) + (isB ? u.h * 4 : 0);
    qf[0][0] = *(const bf16x8*)qp; qf[0][1] = *(const bf16x8*)(qp + 32); sinkv[0] = sk[0];
    if (isB) {
#pragma unroll
        for (int hs = 1; hs < 4; ++hs) { qf[hs][0] = *(const bf16x8*)(qp + hs * 64); qf[hs][1] = *(const bf16x8*)(qp + hs * 64 + 32); sinkv[hs] = sk[hs]; }
    }
}
__device__ __forceinline__ void sample_attn_unit(Frame& F, int su) {
    const int lane = FLANE, li = lane & 15, lg = lane >> 4;
    const bool isB = su >= 3072;
    int n, hh, seg = 0;
    if (!isB) { seg = su % 3; const int t = su / 3; hh = t & 7; n = t >> 3; } else { const int t = su - 3072; hh = t & 7; n = t >> 3; }
    const bf16* zrow = ((bf16*)(F.ws + WS_Z)) + (size_t)(MP + n) * ZP;
    int qcol, kcol, vcol, rs; const float *Kc, *Vc;
    if (!isB) { qcol = hh * 64; kcol = 512 + hh * 64; vcol = 1024 + hh * 64; rs = 512; Kc = inptr(2) + (size_t)n * LA * 512 + hh * 64; Vc = inptr(3) + (size_t)n * LA * 512 + hh * 64; }
    else { const int g = hh >> 2; qcol = 1536 + hh * 64; kcol = 2048 + g * 64; vcol = 2176 + g * 64; rs = 128; Kc = inptr(4) + (size_t)n * LB * 128 + g * 64; Vc = inptr(5) + (size_t)n * LB * 128 + g * 64; }
    float q4[4], kn[4], vn[4];
    { const u32x2v a = *(const u32x2v*)(zrow + qcol + 4 * li), k2 = *(const u32x2v*)(zrow + kcol + 4 * li), v2 = *(const u32x2v*)(zrow + vcol + 4 * li);
      q4[0] = bflo(a.x); q4[1] = bfhi(a.x); q4[2] = bflo(a.y); q4[3] = bfhi(a.y);
      kn[0] = bflo(k2.x); kn[1] = bfhi(k2.x); kn[2] = bflo(k2.y); kn[3] = bfhi(k2.y);
      vn[0] = bflo(v2.x); vn[1] = bfhi(v2.x); vn[2] = bflo(v2.y); vn[3] = bfhi(v2.y); }
    const int step = 1 << (2 * seg);
    float sv[32];
    float mx = NEGBIG;
#pragma unroll
    for (int it = 0; it < 32; ++it) { const int j = 4 * it + lg; const int row = isB ? j : (LA - step * (j + 1));
        const f32x4 kv = __builtin_nontemporal_load((const f32x4*)(Kc + (size_t)row * rs + 4 * li));
        float sx = (q4[0] * kv[0] + q4[1] * kv[1]) + (q4[2] * kv[2] + q4[3] * kv[3]);
        sx += __shfl_xor(sx, 1); sx += __shfl_xor(sx, 2); sx += __shfl_xor(sx, 4); sx += __shfl_xor(sx, 8);
        sv[it] = sx; mx = fmaxf(mx, sx); }
    float snew = (q4[0] * kn[0] + q4[1] * kn[1]) + (q4[2] * kn[2] + q4[3] * kn[3]);
    snew += __shfl_xor(snew, 1); snew += __shfl_xor(snew, 2); snew += __shfl_xor(snew, 4); snew += __shfl_xor(snew, 8);
    mx = fmaxf(mx, snew); mx = fmaxf(mx, __shfl_xor(mx, 16)); mx = fmaxf(mx, __shfl_xor(mx, 32));
    float o4[4] = {0.f, 0.f, 0.f, 0.f}, l = 0.f;
#pragma unroll
    for (int it = 0; it < 32; ++it) { const int j = 4 * it + lg; const int row = isB ? j : (LA - step * (j + 1));
        const float p = __builtin_amdgcn_exp2f(sv[it] - mx); l += p;
        const f32x4 vv = __builtin_nontemporal_load((const f32x4*)(Vc + (size_t)row * rs + 4 * li));
        o4[0] += p * vv[0]; o4[1] += p * vv[1]; o4[2] += p * vv[2]; o4[3] += p * vv[3]; }
#pragma unroll
    for (int c = 0; c < 4; ++c) { o4[c] += __shfl_xor(o4[c], 16); o4[c] += __shfl_xor(o4[c], 32); }
    l += __shfl_xor(l, 16); l += __shfl_xor(l, 32);
    const float pn = __builtin_amdgcn_exp2f(snew - mx);
    l += pn;
#pragma unroll
    for (int c = 0; c < 4; ++c) o4[c] += pn * vn[c];
    float scale = 1.0f / l; const float lse2 = mx + __builtin_amdgcn_logf(l);
    if (isB) scale *= 1.0f / (1.0f + __builtin_amdgcn_exp2f(inptr(14)[hh] * LOG2E - lse2));
    float* so = ((float*)(F.ws + WS_SO)) + (isB ? (size_t)3 * NS * 512 : (size_t)seg * NS * 512) + (size_t)n * 512 + hh * 64 + 4 * li;
    if (lg == 0) *(f32x4*)so = (f32x4){o4[0] * scale, o4[1] * scale, o4[2] * scale, o4[3] * scale};
    if (!isB && lane == 0) ((float*)(F.ws + WS_SSQ3 + 5 * 512 * 1024))[((size_t)seg * NS + n) * 8 + hh] = lse2;
}
__device__ __forceinline__ void p2_attention(Frame& F) {
    const int lane = FLANE;
    constexpr int NU = SWA_NU;
    int U = F.vcu, k = 0;
    const pg8::KCopy kc{(const char*)inptr(2), (const char*)inptr(3), (char*)(F.out + O_SAK), (char*)(F.out + O_SAV), 0, 1 << 30, 0, 1, 0u, 0, 1};
    bf16x8 qcur[4][2], qnxt[4][2]; float scur[4], snxt[4];
    if (U < NU) { const SwaUnit u0 = swa_decode(U); swa_load_q(F, u0, lane, qcur, scur); swa_stage(F, u0, 0, lane); }
    for (; U < NU; U += F.G, ++k) {
        const SwaUnit u = swa_decode(U);
        __syncthreads();
        const int Un = U + F.G;
        f32x4 cpv[2]; char* cpd[2];
#pragma unroll
        for (int e = 0; e < 2; ++e) { const char* sp; kc.addr_id((unsigned)(RIDER_CHUNKS + 2 * k + e) * (unsigned)(F.G * NWAVES) + (unsigned)(F.vcu * NWAVES + F.wave), sp, cpd[e]); cpv[e] = __builtin_nontemporal_load((const f32x4*)sp + lane); }
        if (Un < NU) { const SwaUnit un = swa_decode(Un); swa_load_q(F, un, lane, qnxt, snxt); swa_stage(F, un, (k + 1) & 1, lane); }
        if (u.kind == 3) {
            swa_compute(F, u, k & 1, lane, qcur[0], scur[0], u.h * 4 + 0); swa_compute(F, u, k & 1, lane, qcur[1], scur[1], u.h * 4 + 1);
            swa_compute(F, u, k & 1, lane, qcur[2], scur[2], u.h * 4 + 2); swa_compute(F, u, k & 1, lane, qcur[3], scur[3], u.h * 4 + 3);
        } else swa_compute(F, u, k & 1, lane, qcur[0], scur[0], u.h);
#pragma unroll
        for (int e = 0; e < 2; ++e) __builtin_nontemporal_store(cpv[e], (f32x4*)cpd[e] + lane);
#pragma unroll
        for (int hs = 0; hs < 4; ++hs) { qcur[hs][0] = qnxt[hs][0]; qcur[hs][1] = qnxt[hs][1]; scur[hs] = snxt[hs]; }
    }
    __syncthreads();
    const int gw = F.vcu * NWAVES + F.wave, NGW = F.G * NWAVES;
    for (int su = gw; su < 4096; su += NGW) sample_attn_unit(F, su);
}
__device__ __forceinline__ void unpack8(const v4u v, float (&f)[8]) { f[0] = bflo(v.x); f[1] = bfhi(v.x); f[2] = bflo(v.y); f[3] = bfhi(v.y); f[4] = bflo(v.z); f[5] = bfhi(v.z); f[6] = bflo(v.w); f[7] = bfhi(v.w); }
__device__ __forceinline__ void ld8f(const float* p, float (&f)[8]) { const f32x4 a = *(const f32x4*)p, b = *(const f32x4*)(p + 4); f[0] = a[0]; f[1] = a[1]; f[2] = a[2]; f[3] = a[3]; f[4] = b[0]; f[5] = b[1]; f[6] = b[2]; f[7] = b[3]; }
__device__ __forceinline__ void mix_store(Frame& F, int r, int lane, const float (&a)[8], const float (&bb)[8]) {
    float sa = 0.f, sb = 0.f;
#pragma unroll
    for (int e = 0; e < 8; ++e) { sa += a[e] * a[e]; sb += bb[e] * bb[e]; }
    const float ra = 1.0f / sqrtf(wave_sum(sa) * (1.0f / 512.0f) + EPS), rb = 1.0f / sqrtf(wave_sum(sb) * (1.0f / 512.0f) + EPS);
    v4u oa, ob;
    oa.x = pk2(a[0] * ra, a[1] * ra); oa.y = pk2(a[2] * ra, a[3] * ra); oa.z = pk2(a[4] * ra, a[5] * ra); oa.w = pk2(a[6] * ra, a[7] * ra);
    ob.x = pk2(bb[0] * rb, bb[1] * rb); ob.y = pk2(bb[2] * rb, bb[3] * rb); ob.z = pk2(bb[4] * rb, bb[5] * rb); ob.w = pk2(bb[6] * rb, bb[7] * rb);
    *(v4u*)(((bf16*)(F.ws + WS_OC)) + (size_t)r * D + lane * 8) = oa; *(v4u*)(((bf16*)(F.ws + WS_OC)) + (size_t)r * D + 512 + lane * 8) = ob;
}
__device__ __forceinline__ void p3_mix(Frame& F) {
    const int gw = F.vcu * NWAVES + F.wave, NGW = F.G * NWAVES, lane = FLANE, head = lane >> 3;
    for (int r0 = gw; r0 < MP; r0 += 4 * NGW) {
        v4u po[4][3], obv[4]; float ls[4][3];
#pragma unroll
        for (int q = 0; q < 4; ++q) { const int r = r0 + q * NGW < MP ? r0 + q * NGW : MP - 1;
#pragma unroll
            for (int k = 0; k < 3; ++k) { ls[q][k] = ((float*)(F.ws + WS_PL))[(size_t)k * MP * 8 + (size_t)r * 8 + head]; po[q][k] = *(const v4u*)(((bf16*)(F.ws + WS_PO)) + (size_t)k * MP * 512 + (size_t)r * 512 + lane * 8); }
            obv[q] = *(const v4u*)(((bf16*)(F.ws + WS_OB)) + (size_t)r * 512 + lane * 8); }
#pragma unroll
        for (int q = 0; q < 4; ++q) { const int r = r0 + q * NGW < MP ? r0 + q * NGW : MP - 1;
            const float mxl = fmaxf(fmaxf(ls[q][0], ls[q][1]), ls[q][2]);
            float w[3], ws = 0.f;
#pragma unroll
            for (int k = 0; k < 3; ++k) { w[k] = __builtin_amdgcn_exp2f(ls[q][k] - mxl); ws += w[k]; }
            const float wi = 1.0f / ws;
            float a[8], bb[8];
#pragma unroll
            for (int e = 0; e < 8; ++e) a[e] = 0.f;
#pragma unroll
            for (int k = 0; k < 3; ++k) { const v4u v = po[q][k]; const float wk = w[k] * wi;
                a[0] += wk * bflo(v.x); a[1] += wk * bfhi(v.x); a[2] += wk * bflo(v.y); a[3] += wk * bfhi(v.y); a[4] += wk * bflo(v.z); a[5] += wk * bfhi(v.z); a[6] += wk * bflo(v.w); a[7] += wk * bfhi(v.w); }
            unpack8(obv[q], bb);
            mix_store(F, r, lane, a, bb); }
    }
    for (int r = MP + gw; r < MT; r += NGW) {
        const int n = r - MP;
        const float* SL = (const float*)(F.ws + WS_SSQ3 + 5 * 512 * 1024);
        float ls[3], mxl = NEGBIG;
#pragma unroll
        for (int k = 0; k < 3; ++k) { ls[k] = SL[((size_t)k * NS + n) * 8 + head]; mxl = fmaxf(mxl, ls[k]); }
        float w[3], wsum = 0.f;
#pragma unroll
        for (int k = 0; k < 3; ++k) { w[k] = __builtin_amdgcn_exp2f(ls[k] - mxl); wsum += w[k]; }
        const float wi = 1.0f / wsum;
        float a[8], bb[8];
#pragma unroll
        for (int e = 0; e < 8; ++e) a[e] = 0.f;
#pragma unroll
        for (int k = 0; k < 3; ++k) { const float* so = ((const float*)(F.ws + WS_SO)) + ((size_t)k * NS + n) * 512 + lane * 8; const f32x4 a0 = *(const f32x4*)so, a1 = *(const f32x4*)(so + 4); const float wk = w[k] * wi;
            a[0] += wk * a0[0]; a[1] += wk * a0[1]; a[2] += wk * a0[2]; a[3] += wk * a0[3]; a[4] += wk * a1[0]; a[5] += wk * a1[1]; a[6] += wk * a1[2]; a[7] += wk * a1[3]; }
        ld8f(((const float*)(F.ws + WS_SO)) + ((size_t)3 * NS + n) * 512 + lane * 8, bb);
        mix_store(F, r, lane, a, bb);
    }
}
__device__ __forceinline__ void cross_stage_q(Frame& F, int b, int hx, int quarter, int buf, int lane) {
    const bf16* MKp = (const bf16*)(F.ws + WS_MK); const bf16* MVp = (const bf16*)(F.ws + WS_MV);
#pragma unroll
    for (int i = 0; i < 4; ++i) {
        const int piece = F.wave * 4 + i, row = piece * 2 + (lane >> 5), cpos = lane & 31;
        const int ck = cpos ^ (row & 15), cv = 2 * ((cpos >> 1) ^ (row & 7)) + (cpos & 1);
        const size_t grow = (size_t)(b * 256 + quarter * 64 + row) * 1024 + hx * 256;
        __builtin_amdgcn_global_load_lds((const unsigned*)(MKp + grow + ck * 8), (LAS unsigned*)(F.lds + buf * 65536 + piece * 1024), 16, 0, 0);
        __builtin_amdgcn_global_load_lds((const unsigned*)(MVp + grow + cv * 8), (LAS unsigned*)(F.lds + buf * 65536 + 32768 + piece * 1024), 16, 0, 0);
    }
}
__device__ __forceinline__ void cross_load_q(Frame& F, int b, int hx, int q0, int lane, bf16x8 (&qf)[8]) {
    const bf16* qp = ((const bf16*)(F.ws + WS_QX)) + ((size_t)b * S + q0 + F.wave * 16 + (lane & 15)) * 1024 + hx * 256 + 8 * (lane >> 4);
#pragma unroll
    for (int ks = 0; ks < 8; ++ks) qf[ks] = *(const bf16x8*)(qp + ks * 32);
}
template <bool SAMPLE> __device__ __forceinline__ void cross_cu(Frame& F, int b, int hx, int qbase, int lane_in) {
    int lane = lane_in; asm volatile("" : "+v"(lane));
    const int c = lane & 15, g = lane >> 4, q = (lane & 15) >> 2, pp = lane & 3, rl = 4 * g + q;
    int kx[8], vx[16];
#pragma unroll
    for (int ks = 0; ks < 8; ++ks) kx[ks] = c * 512 + (((ks * 4 + g) ^ c) * 16);
#pragma unroll
    for (int dt = 0; dt < 16; ++dt) vx[dt] = 32768 + rl * 512 + pp * 8 + ((dt ^ (rl & 7)) * 32);
    bf16x8 qf[8];
    cross_load_q(F, b, hx, qbase, lane, qf);
    const int sli = lane & 15, slg = lane >> 4;
    LAS float* scs = (LAS float*)(F.lds + COPY_OFF); LAS float* spart = scs + 256;
    f32x4 sq[4], so[4]; float smx = 0.f, sl = 1.f, sl0 = 1.f;
#pragma unroll
    for (int j = 0; j < 4; ++j) { so[j] = (f32x4){0.f, 0.f, 0.f, 0.f}; sq[j] = (f32x4){0.f, 0.f, 0.f, 0.f}; }
    const float* cmk = nullptr; const float* cmv = nullptr;
    if constexpr (SAMPLE) { cmk = inptr(6); cmv = inptr(7);
        const bf16* sqp = ((const bf16*)(F.ws + WS_QX)) + (size_t)(MP + (F.vcu >> 2)) * 1024 + (F.vcu & 3) * 256 + sli * 4;
#pragma unroll
        for (int j = 0; j < 4; ++j) { const u32x2v a = *(const u32x2v*)(sqp + j * 64); sq[j] = (f32x4){bflo(a.x), bfhi(a.x), bflo(a.y), bfhi(a.y)}; } }
    cross_stage_q(F, b, hx, 0, 0, lane);
    int st = 0;
#pragma unroll 1
    for (int ps = 0; ps < 4; ++ps) {
        float m = NEGBIG, l = 0.f; f32x4 o[16];
#pragma unroll
        for (int dt = 0; dt < 16; ++dt) o[dt] = (f32x4){0.f, 0.f, 0.f, 0.f};
#pragma unroll 1
        for (int qd = 0; qd < 4; ++qd, ++st) {
            __syncthreads();
            f32x4 sld[2][4]; int skey[2] = {0, 0}; const bool svp = (st >> 2) & 1;
            if constexpr (SAMPLE) {
                const int su = F.vcu + (st >> 3) * 256, sn = su >> 2, shx = su & 3;
                if (st == 8) {
                    const int t_ = FTID; if (t_ < 256) { float a_ = 0.f;
#pragma unroll
                        for (int k = 0; k < 8; ++k) a_ += spart[k * 256 + t_];
                        ((bf16*)(F.ws + WS_OX))[(size_t)(MP + (F.vcu >> 2)) * 1024 + (F.vcu & 3) * 256 + t_] = (bf16)f2bf(a_ / sl0); }
                    const bf16* sqp = ((const bf16*)(F.ws + WS_QX)) + (size_t)(MP + sn) * 1024 + shx * 256 + sli * 4;
#pragma unroll
                    for (int j = 0; j < 4; ++j) { const u32x2v a = *(const u32x2v*)(sqp + j * 64); sq[j] = (f32x4){bflo(a.x), bfhi(a.x), bflo(a.y), bfhi(a.y)}; } }
                if ((st & 7) == 4) {
                    const f32x4 s4 = *(LAS const f32x4*)(scs + 4 * lane);
                    float mx_ = fmaxf(fmaxf(s4[0], s4[1]), fmaxf(s4[2], s4[3]));
#pragma unroll
                    for (int o_ = 1; o_ < 64; o_ <<= 1) mx_ = fmaxf(mx_, __shfl_xor(mx_, o_));
                    float l_ = __builtin_amdgcn_exp2f(s4[0] - mx_) + __builtin_amdgcn_exp2f(s4[1] - mx_) + __builtin_amdgcn_exp2f(s4[2] - mx_) + __builtin_amdgcn_exp2f(s4[3] - mx_);
                    smx = mx_; sl = wave_sum(l_); }
                const float* mp_ = (svp ? cmv : cmk);
#pragma unroll
                for (int g2 = 0; g2 < 2; ++g2) { skey[g2] = 32 * F.wave + 8 * (st & 3) + 4 * g2 + slg;
                    const float* rp_ = mp_ + (((size_t)sn * MEMT + skey[g2]) * 4 + shx) * 256 + sli * 4;
#pragma unroll
                    for (int j = 0; j < 4; ++j) sld[g2][j] = __builtin_nontemporal_load((const f32x4*)(rp_ + j * 64)); }
            }
            if (!(qd == 3 && ps == 3)) cross_stage_q(F, b, hx, (qd + 1) & 3, (st + 1) & 1, lane);
#pragma unroll 1
            for (int jj = 0; jj < 2; ++jj) {
                LAS const unsigned char* base = F.lds + (st & 1) * 65536 + jj * 16384;
                f32x4 s0 = (f32x4){0.f, 0.f, 0.f, 0.f}, s1 = (f32x4){0.f, 0.f, 0.f, 0.f};
#pragma unroll
                for (int ks = 0; ks < 8; ++ks) { const bf16x8 k0 = *(LAS const bf16x8*)(base + kx[ks]), k1 = *(LAS const bf16x8*)(base + 8192 + kx[ks]);
                    s0 = __builtin_amdgcn_mfma_f32_16x16x32_bf16(k0, qf[ks], s0, 0, 0, 0); s1 = __builtin_amdgcn_mfma_f32_16x16x32_bf16(k1, qf[ks], s1, 0, 0, 0); }
                float tm = fmaxf(fmaxf(fmaxf(s0[0], s0[1]), fmaxf(s0[2], s0[3])), fmaxf(fmaxf(s1[0], s1[1]), fmaxf(s1[2], s1[3])));
                tm = fmaxf(tm, __shfl_xor(tm, 16)); tm = fmaxf(tm, __shfl_xor(tm, 32));
                const float mn = fmaxf(m, tm), alpha = __builtin_amdgcn_exp2f(m - mn); m = mn;
                float p0[4], p1[4], psum = 0.f;
#pragma unroll
                for (int i = 0; i < 4; ++i) { p0[i] = __builtin_amdgcn_exp2f(s0[i] - mn); p1[i] = __builtin_amdgcn_exp2f(s1[i] - mn); psum += p0[i] + p1[i]; }
                l = l * alpha + psum;
#pragma unroll
                for (int dt = 0; dt < 16; ++dt) o[dt] = o[dt] * alpha;
                const bf16x8 pb = __builtin_bit_cast(bf16x8, (v4u){pg8::cvt_pk_bf16(p0[0], p0[1]), pg8::cvt_pk_bf16(p0[2], p0[3]), pg8::cvt_pk_bf16(p1[0], p1[1]), pg8::cvt_pk_bf16(p1[2], p1[3])});
                const unsigned vbase = lds_addr(base);
#pragma unroll
                for (int d4 = 0; d4 < 4; ++d4) {
                    s16x4 lo_[4], hh_[4];
#pragma unroll
                    for (int e = 0; e < 4; ++e) { const unsigned a_ = vbase + (unsigned)vx[4 * d4 + e]; VTRA(lo_[e], a_, 0); VTRA(hh_[e], a_, 8192); }
                    LGKM0();
#pragma unroll
                    for (int e = 0; e < 4; ++e) { const bf16x8 vf = (bf16x8){lo_[e][0], lo_[e][1], lo_[e][2], lo_[e][3], hh_[e][0], hh_[e][1], hh_[e][2], hh_[e][3]};
                        o[4 * d4 + e] = __builtin_amdgcn_mfma_f32_16x16x32_bf16(vf, pb, o[4 * d4 + e], 0, 0, 0); }
                }
            }
            if constexpr (SAMPLE) {
                if (!svp) {
#pragma unroll
                    for (int g2 = 0; g2 < 2; ++g2) { float d_ = 0.f;
#pragma unroll
                        for (int j = 0; j < 4; ++j) d_ += (sq[j][0] * sld[g2][j][0] + sq[j][1] * sld[g2][j][1]) + (sq[j][2] * sld[g2][j][2] + sq[j][3] * sld[g2][j][3]);
                        d_ += __shfl_xor(d_, 1); d_ += __shfl_xor(d_, 2); d_ += __shfl_xor(d_, 4); d_ += __shfl_xor(d_, 8);
                        if (sli == 0) scs[skey[g2]] = d_; }
                } else {
#pragma unroll
                    for (int g2 = 0; g2 < 2; ++g2) { const float p_ = __builtin_amdgcn_exp2f(scs[skey[g2]] - smx);
#pragma unroll
                        for (int j = 0; j < 4; ++j) so[j] = so[j] + sld[g2][j] * p_; }
                    if ((st & 3) == 3) {
#pragma unroll
                        for (int j = 0; j < 4; ++j) {
#pragma unroll
                            for (int e = 0; e < 4; ++e) { float v_ = so[j][e]; v_ += __shfl_xor(v_, 16); v_ += __shfl_xor(v_, 32); so[j][e] = v_; }
                            if (slg == 0) *(LAS f32x4*)(spart + F.wave * 256 + j * 64 + sli * 4) = so[j];
                            so[j] = (f32x4){0.f, 0.f, 0.f, 0.f}; }
                        if ((st >> 3) == 0) sl0 = sl; }
                }
            }
        }
        if (ps < 3) cross_load_q(F, b, hx, qbase + (ps + 1) * 128, lane, qf);
        float lt = l; lt += __shfl_xor(lt, 16); lt += __shfl_xor(lt, 32); const float linv = 1.0f / lt;
        bf16* op = ((bf16*)(F.ws + WS_OX)) + ((size_t)b * S + qbase + ps * 128 + F.wave * 16 + c) * 1024 + hx * 256 + 4 * g;
#pragma unroll
        for (int dt = 0; dt < 16; ++dt) { u32x2v wv; wv.x = pg8::cvt_pk_bf16(o[dt][0] * linv, o[dt][1] * linv); wv.y = pg8::cvt_pk_bf16(o[dt][2] * linv, o[dt][3] * linv); *(u32x2v*)(op + 16 * dt) = wv; }
    }
    __syncthreads();
    if constexpr (SAMPLE) { const int t_ = FTID; const int su = F.vcu + 256;
        if (t_ < 256) { float a_ = 0.f;
#pragma unroll
            for (int k = 0; k < 8; ++k) a_ += spart[k * 256 + t_];
            ((bf16*)(F.ws + WS_OX))[(size_t)(MP + (su >> 2)) * 1024 + (su & 3) * 256 + t_] = (bf16)f2bf(a_ / sl); } }
}
__device__ __forceinline__ void cross_sample_unit(Frame& F, int n, int hx) {
    const int lane = FLANE, w = F.wave;
    LAS float* scs = (LAS float*)F.lds;
    LAS float* part = (LAS float*)(F.lds + 1024);
    float q4[4];
    { const u32x2v a = *(const u32x2v*)(((bf16*)(F.ws + WS_QX)) + (size_t)(MP + n) * 1024 + hx * 256 + 4 * lane); q4[0] = bflo(a.x); q4[1] = bfhi(a.x); q4[2] = bflo(a.y); q4[3] = bfhi(a.y); }
    const float* Kc = inptr(6) + ((size_t)n * MEMT * 4 + hx) * 256 + 4 * lane;
    const float* Vc = inptr(7) + ((size_t)n * MEMT * 4 + hx) * 256 + 4 * lane;
#pragma unroll 8
    for (int kk = 0; kk < 32; ++kk) { const int key = w * 32 + kk; const f32x4 kv = __builtin_nontemporal_load((const f32x4*)(Kc + (size_t)key * 1024));
        float s = (q4[0] * kv[0] + q4[1] * kv[1]) + (q4[2] * kv[2] + q4[3] * kv[3]); s = wave_sum(s);
        if (lane == 0) scs[key] = s; }
    __syncthreads();
    const f32x4 s4 = *(LAS const f32x4*)(scs + 4 * lane);
    float mx = fmaxf(fmaxf(s4[0], s4[1]), fmaxf(s4[2], s4[3]));
#pragma unroll
    for (int o = 1; o < 64; o <<= 1) mx = fmaxf(mx, __shfl_xor(mx, o));
    float l = __builtin_amdgcn_exp2f(s4[0] - mx) + __builtin_amdgcn_exp2f(s4[1] - mx) + __builtin_amdgcn_exp2f(s4[2] - mx) + __builtin_amdgcn_exp2f(s4[3] - mx);
    l = wave_sum(l);
    float o4[4] = {0.f, 0.f, 0.f, 0.f};
#pragma unroll 8
    for (int kk = 0; kk < 32; ++kk) { const int key = w * 32 + kk; const float p = __builtin_amdgcn_exp2f(scs[key] - mx); const f32x4 vv = __builtin_nontemporal_load((const f32x4*)(Vc + (size_t)key * 1024));
        o4[0] += p * vv[0]; o4[1] += p * vv[1]; o4[2] += p * vv[2]; o4[3] += p * vv[3]; }
    *(LAS f32x4*)(part + w * 256 + 4 * lane) = (f32x4){o4[0], o4[1], o4[2], o4[3]};
    __syncthreads();
    if (FTID < 256) { float s = 0.f;
#pragma unroll
        for (int k = 0; k < 8; ++k) s += part[k * 256 + FTID];
        ((bf16*)(F.ws + WS_OX))[(size_t)(MP + n) * 1024 + hx * 256 + FTID] = (bf16)f2bf(s / l); }
    __syncthreads();
}
#ifndef XNQT
#define XNQT 1
#endif
__device__ __forceinline__ void p6_cross(Frame& F) {
    const int lane = FLANE;
    for (int du = F.vcu; du < 256; du += F.G) {
        const int pair = du >> 3, b = pair >> 2, hx = pair & 3;
        if (F.G == 256) cross_cu<true>(F, b, hx, 512 * (du & 7), lane); else cross_cu<false>(F, b, hx, 512 * (du & 7), lane);
    }
    __syncthreads();
    if (F.G != 256) { for (int u = F.vcu; u < NS * 4; u += F.G) cross_sample_unit(F, u >> 2, u & 3); }
}
__device__ __forceinline__ void conv_row(const float (&g0)[8], const float (&g1)[8], const float (&g2)[8], const float (&vl)[8], const float (&w0)[8], const float (&w1)[8], const float (&w2)[8], const float (&cb)[8], bf16* dst) {
    float a[8];
#pragma unroll
    for (int e = 0; e < 8; ++e) { const float c = cb[e] + w0[e] * g0[e] + w1[e] * g1[e] + w2[e] * g2[e]; a[e] = c / (1.0f + __builtin_amdgcn_exp2f(-c * LOG2E)) * vl[e]; }
    v4u o; o.x = pk2(a[0], a[1]); o.y = pk2(a[2], a[3]); o.z = pk2(a[4], a[5]); o.w = pk2(a[6], a[7]);
    *(v4u*)dst = o;
}
__device__ __forceinline__ void p9_conv(Frame& F) {
    const long gtid = (long)F.vcu * (NWAVES * 64) + FTID, gthreads = (long)F.G * (NWAVES * 64);
    constexpr int CH = DFF / 8;
    const float* stc_ = inptr(8); const float* cw_ = inptr(23); const float* cbp_ = inptr(24);
    const bf16* GVp = (const bf16*)(F.ws + WS_GV); bf16* ACTp = (bf16*)(F.ws + WS_ACT);
    {
        const float* halo = (const float*)(F.ws + WS_GV);
        for (long i = gtid; i < (long)128 * 2 * CH; i += gthreads) {
            const int pm = (int)(i / (2 * CH)), rem = (int)(i - (long)pm * 2 * CH), ur = rem / CH, j0 = (rem - ur * CH) * 8;
            if ((pm & 15) == 0) continue;
            float g0[8], g1[8], g2[8], vl[8], w0[8], w1[8], w2[8], cb[8];
            const float* HLp = halo + ((size_t)(pm - 1) * 2) * DFF + j0; const float* HGp = halo + ((size_t)(128 + pm) * 2) * DFF + j0; const float* HVp = halo + ((size_t)(256 + pm) * 2) * DFF + j0;
            if (ur == 0) { ld8f(HLp, g0); ld8f(HLp + DFF, g1); ld8f(HGp, g2); ld8f(HVp, vl); } else { ld8f(HLp + DFF, g0); ld8f(HGp, g1); ld8f(HGp + DFF, g2); ld8f(HVp + DFF, vl); }
            ld8f(cw_ + j0, w0); ld8f(cw_ + DFF + j0, w1); ld8f(cw_ + 2 * DFF + j0, w2); ld8f(cbp_ + j0, cb);
            conv_row(g0, g1, g2, vl, w0, w1, w2, cb, ACTp + ((size_t)pm * 256 + ur) * DFF + j0);
        }
    }
    for (long i = gtid; i < (long)NS * CH; i += gthreads) {
        const int n = (int)(i / CH), j0 = (int)(i - (long)n * CH) * 8, r = MP + n;
        float g0[8], g1[8], g2[8], vl[8], w0[8], w1[8], w2[8], cb[8];
        unpack8(*(const v4u*)(GVp + (size_t)r * UPN + j0), g2); unpack8(*(const v4u*)(GVp + (size_t)r * UPN + DFF + j0), vl);
        ld8f(stc_ + ((size_t)n * 2 + 0) * DFF + j0, g0); ld8f(stc_ + ((size_t)n * 2 + 1) * DFF + j0, g1);
        ld8f(cw_ + j0, w0); ld8f(cw_ + DFF + j0, w1); ld8f(cw_ + 2 * DFF + j0, w2); ld8f(cbp_ + j0, cb);
        conv_row(g0, g1, g2, vl, w0, w1, w2, cb, ACTp + (size_t)r * DFF + j0);
        float* so = F.out + O_SCV + ((size_t)n * 2 + 1) * DFF + j0; *(f32x4*)so = (f32x4){g2[0], g2[1], g2[2], g2[3]}; *(f32x4*)(so + 4) = (f32x4){g2[4], g2[5], g2[6], g2[7]};
    }
}
__device__ __forceinline__ void p11_final(Frame& F) {
    const int gw = F.vcu * NWAVES + F.wave, NGW = F.G * NWAVES, lane = FLANE;
    const float* gf_ = inptr(26);
    f32x4 g[4];
#pragma unroll
    for (int j = 0; j < 4; ++j) g[j] = ((const f32x4*)gf_)[lane + 64 * j];
    const bf16* X3 = (const bf16*)(F.ws + WS_XN);
    for (int r0 = gw; r0 < MT; r0 += 4 * NGW) {
        u32x2v v[4][4]; float tot[4];
#pragma unroll
        for (int k = 0; k < 4; ++k) { const int r = r0 + k * NGW < MT ? r0 + k * NGW : MT - 1;
            tot[k] = lane < 16 ? ((float*)(F.ws + WS_SSQ3))[(size_t)r * 16 + lane] : 0.f;
#pragma unroll
            for (int j = 0; j < 4; ++j) v[k][j] = ((const u32x2v*)(X3 + (size_t)r * D))[lane + 64 * j]; }
#pragma unroll
        for (int k = 0; k < 4; ++k) { const int r = r0 + k * NGW < MT ? r0 + k * NGW : MT - 1;
            const float rstd = 1.0f / sqrtf(wave_sum(tot[k]) * (1.0f / D) + EPS);
            f32x4* yr = (f32x4*)(F.out + (size_t)r * D) + lane;
#pragma unroll
            for (int j = 0; j < 4; ++j) { const f32x4 x = (f32x4){bflo(v[k][j].x), bfhi(v[k][j].x), bflo(v[k][j].y), bfhi(v[k][j].y)}; __builtin_nontemporal_store(x * rstd * g[j], yr + 64 * j); } }
    }
}

template <class E>
__device__ __forceinline__ void sgemm(Frame& F, const bf16* X  , const bf16* Bt  , int N, int K, const E& e) {
    const int lane = FLANE, fr = lane & 15, fq = lane >> 4, items = 8 * (N / 16), nks = K / 32;
    for (int it = F.wave * F.G + F.vcu; it < items; it += NWAVES * F.G) {
        const int tt = it & 7, ct = it >> 3, n = tt * 16 + fr;
        const bf16* xp = X + (size_t)n * K + fq * 8;
        const bf16* wp = Bt + (size_t)(ct * 16 + fr) * K + fq * 8;
        f32x4 acc = (f32x4){0.f, 0.f, 0.f, 0.f};
#pragma unroll 16
        for (int ks = 0; ks < nks; ++ks) acc = __builtin_amdgcn_mfma_f32_16x16x32_bf16(*(const bf16x8*)(wp + ks * 32), *(const bf16x8*)(xp + ks * 32), acc, 0, 0, 0);
        float carry = 0.f;
        e.tile(n, ct * 16 + 4 * fq, acc, carry);
        e.finish(n, fq, carry);
    }
}
struct SEpiInProj {
    bf16* Z; float* out;
    __device__ __forceinline__ void tile(int n, int c0, const f32x4 v, float&) const {
        bf16* zrow = Z + (size_t)(MP + n) * ZP;
        const bool is_v = (c0 >= 1024 && c0 < 1536) || c0 >= 2176;
        if (is_v) {
            u32x2v w; w.x = pg8::cvt_pk_bf16(v[0], v[1]); w.y = pg8::cvt_pk_bf16(v[2], v[3]); *(u32x2v*)(zrow + c0) = w;
            float* so = (c0 < 2048) ? out + O_SAV + ((size_t)n * LA + (LA - 1)) * 512 + (c0 - 1024) : out + O_SBV + ((size_t)n * LB + (LB - 1)) * 128 + (c0 - 2176);
            *(f32x4*)so = v;
        } else {
            const int hb = c0 & ~63, d = (c0 & 63) >> 1;
            float o1[2], o2[2];
#pragma unroll
            for (int i = 0; i < 2; ++i) { float rev = 16384.0f * (__builtin_amdgcn_exp2f(-(float)(d + i) * (13.287712379549449f / 32.0f)) * 0.15915494309189535f); rev -= __builtin_floorf(rev);
                const float cs = __builtin_amdgcn_cosf(rev), sn = __builtin_amdgcn_sinf(rev), x1 = v[2 * i], x2 = v[2 * i + 1]; o1[i] = x1 * cs - x2 * sn; o2[i] = x2 * cs + x1 * sn; }
            const bool is_q = (c0 < 512) || (c0 >= 1536 && c0 < 2048);
            if (is_q) { o1[0] *= QSCALE64; o1[1] *= QSCALE64; o2[0] *= QSCALE64; o2[1] *= QSCALE64; }
            *(unsigned*)(zrow + hb + d) = pg8::cvt_pk_bf16(o1[0], o1[1]); *(unsigned*)(zrow + hb + 32 + d) = pg8::cvt_pk_bf16(o2[0], o2[1]);
            if (!is_q) {
                float* so = (c0 < 2048) ? out + O_SAK + ((size_t)n * LA + (LA - 1)) * 512 + (hb - 512) + d : out + O_SBK + ((size_t)n * LB + (LB - 1)) * 128 + (hb - 2048) + d;
                typedef float f32x2s __attribute__((ext_vector_type(2)));
                *(f32x2s*)so = (f32x2s){o1[0], o1[1]}; *(f32x2s*)(so + 32) = (f32x2s){o2[0], o2[1]};
            }
        }
    }
    __device__ __forceinline__ void finish(int, int, float) const {}
};
template <bool FIRST> struct SEpiResid {
    const float* xs; bf16* xb; float* ssq;
    __device__ __forceinline__ void tile(int n, int c0, f32x4 v, float& carry) const {
        const size_t r = (size_t)(MP + n);
        if (FIRST) v = v + *(const f32x4*)(xs + (size_t)n * D + c0);
        else { const u32x2v x = *(const u32x2v*)(xb + r * D + c0); v[0] += bflo(x.x); v[1] += bfhi(x.x); v[2] += bflo(x.y); v[3] += bfhi(x.y); }
        carry += (v[0] * v[0] + v[1] * v[1]) + (v[2] * v[2] + v[3] * v[3]);
        u32x2v w; w.x = pg8::cvt_pk_bf16(v[0], v[1]); w.y = pg8::cvt_pk_bf16(v[2], v[3]); *(u32x2v*)(xb + r * D + c0) = w;
    }
    __device__ __forceinline__ void finish(int n, int fq, float carry) const {
        carry += __shfl_xor(carry, 16); carry += __shfl_xor(carry, 32);
        if (fq == 0) atomicAdd(ssq + (size_t)(MP + n) * 16, carry);
    }
};
struct SEpiScale {
    bf16* O; int ldc; const float* ssq; float scale; int up_perm;
    __device__ __forceinline__ void tile(int n, int c0, const f32x4 v, float&) const {
        const size_t r = (size_t)(MP + n);
        const f32x4 s0 = *(const f32x4*)(ssq + r * 16), s1 = *(const f32x4*)(ssq + r * 16 + 4), s2 = *(const f32x4*)(ssq + r * 16 + 8), s3 = *(const f32x4*)(ssq + r * 16 + 12);
        const f32x4 st = (s0 + s1) + (s2 + s3); const float sc = __builtin_amdgcn_rsqf(((st[0] + st[1]) + (st[2] + st[3])) * (1.0f / D) + EPS) * scale;
        const int col = up_perm ? ((c0 & 128) ? DFF : 0) + (c0 >> 8) * 128 + (c0 & 127) : c0;
        u32x2v w; w.x = pg8::cvt_pk_bf16(v[0] * sc, v[1] * sc); w.y = pg8::cvt_pk_bf16(v[2] * sc, v[3] * sc); *(u32x2v*)(O + r * ldc + col) = w;
    }
    __device__ __forceinline__ void finish(int, int, float) const {}
};
struct Args { const float* in[27]; float* out; unsigned char* ws; int ph_lo, ph_hi; };
__global__ void __launch_bounds__(NWAVES * 64, 2) fwd(Args args) {
    extern __shared__ __attribute__((aligned(16))) unsigned char lds[];
    Frame F;
    F.lds = (LAS unsigned char*)lds;
    F.MISC = (volatile LAS unsigned*)(F.lds + MISC_OFF);
    F.wave = __builtin_amdgcn_readfirstlane((int)threadIdx.x >> 6);
    F.G = gridDim.x; { const int bx = blockIdx.x; F.vcu = (F.G % 8 == 0) ? (bx % 8) * (F.G / 8) + bx / 8 : bx; }
    F.ws = args.ws; F.out = args.out; F.ctl = (gu32*)(F.ws + WS_CTL);
    for (int u = FTID; u < (LDS_BYTES - LDSCTL_OFF) / 4; u += NWAVES * 64) ((LAS unsigned*)(F.lds + LDSCTL_OFF))[u] = 0u;
    __syncthreads();
    XcdBarrier bar; bar.bar = (unsigned*)(F.ctl + CW_BAR); bar.x = 0; bar.st = nullptr;
    if (N_LAUNCHES == 1) bar = xcd_barrier_post((unsigned*)(F.ctl + CW_BAR), F.MISC + 8);
    const int lo = args.ph_lo, hi = args.ph_hi;
#define IN(k) (lo <= (k) && (k) < hi)
#define SEAM(k) do { if (IN(k) && IN((k) + 1)) xcd_barrier(bar); } while (0)
    typedef pg8::bf16_t pb;
#define MKCOPY(j0_, quota_) pg8::KCopy{(const char*)inptr(2), (const char*)inptr(3), (char*)(F.out + O_SAK), (char*)(F.out + O_SAV), (j0_), (quota_), F.vcu * NWAVES + F.wave, F.G * NWAVES, (unsigned)COPY_OFF, 0, 1}
#define MKCOPY2(j0_, quota_, xj0_, xquota_) pg8::KCopy2{(const char*)inptr(2), (const char*)inptr(3), (char*)(F.out + O_SAK), (char*)(F.out + O_SAV), (j0_), (quota_), F.vcu * NWAVES + F.wave, F.G * NWAVES, (unsigned)COPY_OFF, (xj0_), (xquota_)}
    if (IN(0)) { p0_prologue(F); }
    SEAM(0);
    if (IN(1)) {
        { SEpiInProj e{((bf16*)(F.ws + WS_Z)), F.out}; sgemm(F, ((bf16*)(F.ws + WS_XN)) + (size_t)MP * D, ((bf16*)(F.ws + WS_WIN)), ZP, D, e); }
        { pg8::Gemm g{(const pb*)((bf16*)(F.ws + WS_XN)), (const pb*)((bf16*)(F.ws + WS_WIN)), MP, ZP, D}; pg8::StaticOrder So; So.init(MP, ZP, F.G, (int)blockIdx.x);
          pg8::EpiInProj E{(pb*)((bf16*)(F.ws + WS_Z)), F.out};
          pg8::gemm_phase<pg8::EpiInProj, pg8::StaticOrder, true, true, pg8::KCopy>(F.lds, g, So, E, MKCOPY(0, 64)); }
        { pg8::Gemm g{(const pb*)((bf16*)(F.ws + WS_MEMN)), (const pb*)((bf16*)(F.ws + WS_WMKV)), NB * MEMT, 2048, D}; pg8::StaticOrder So; So.init(NB * MEMT, 2048, F.G, (int)((blockIdx.x + F.G - (128 % F.G)) % F.G));
          pg8::EpiMemKV E{(pb*)((bf16*)(F.ws + WS_MK)), (pb*)((bf16*)(F.ws + WS_MV)), F.out};
          pg8::gemm_phase<pg8::EpiMemKV, pg8::StaticOrder, true, true>(F.lds, g, So, E); }
    }
    SEAM(1);
    if (IN(2)) { p2_attention(F); }
    SEAM(2);
    if (IN(3)) { p3_mix(F); }
    SEAM(3);
    if (IN(4)) {
        { SEpiResid<true> e{inptr(1), ((bf16*)(F.ws + WS_XN)), ((float*)(F.ws + WS_SSQ1))}; sgemm(F, ((bf16*)(F.ws + WS_OC)) + (size_t)MP * D, ((bf16*)(F.ws + WS_WOUT)), D, D, e); }
        pg8::Gemm g{(const pb*)((bf16*)(F.ws + WS_OC)), (const pb*)((bf16*)(F.ws + WS_WOUT)), MP, D, D}; pg8::StaticOrder So; So.init(MP, D, F.G, (int)blockIdx.x);
        pg8::EpiResid<true> E{inptr(0), (pb*)((bf16*)(F.ws + WS_XN)), ((float*)(F.ws + WS_SSQ1))};
        pg8::gemm_phase<pg8::EpiResid<true>, pg8::StaticOrder, true, true, pg8::KCopy>(F.lds, g, So, E, MKCOPY(64, 32));
    }
    SEAM(4);
    if (IN(5)) {
        { SEpiScale e{((bf16*)(F.ws + WS_QX)), D, ((float*)(F.ws + WS_SSQ1)), QSCALE256, 0}; sgemm(F, ((bf16*)(F.ws + WS_XN)) + (size_t)MP * D, ((bf16*)(F.ws + WS_WXQ)), D, D, e); }
        pg8::Gemm g{(const pb*)((bf16*)(F.ws + WS_XN)), (const pb*)((bf16*)(F.ws + WS_WXQ)), MP, D, D}; pg8::StaticOrder So; So.init(MP, D, F.G, (int)blockIdx.x);
        pg8::EpiScaleBf16 E{(pb*)((bf16*)(F.ws + WS_QX)), D, ((float*)(F.ws + WS_SSQ1)), QSCALE256};
        pg8::gemm_phase<pg8::EpiScaleBf16, pg8::StaticOrder, true, true, pg8::KCopy>(F.lds, g, So, E, MKCOPY(96, 32));
    }
    SEAM(5);
    if (IN(6)) { p6_cross(F); }
    SEAM(6);
    if (IN(7)) {
        { SEpiResid<false> e{nullptr, ((bf16*)(F.ws + WS_XN)), ((float*)(F.ws + WS_SSQ2))}; sgemm(F, ((bf16*)(F.ws + WS_OX)) + (size_t)MP * D, ((bf16*)(F.ws + WS_WXO)), D, D, e); }
        pg8::Gemm g{(const pb*)((bf16*)(F.ws + WS_OX)), (const pb*)((bf16*)(F.ws + WS_WXO)), MP, D, D}; pg8::StaticOrder So; So.init(MP, D, F.G, (int)blockIdx.x);
        pg8::EpiResid<false> E{nullptr, (pb*)((bf16*)(F.ws + WS_XN)), ((float*)(F.ws + WS_SSQ2))};
        pg8::gemm_phase<pg8::EpiResid<false>, pg8::StaticOrder, true, true, pg8::KCopy>(F.lds, g, So, E, MKCOPY(128, 32));
    }
    SEAM(7);
    if (IN(8)) {
        { SEpiScale e{((bf16*)(F.ws + WS_GV)), UPN, ((float*)(F.ws + WS_SSQ2)), 1.0f, 1}; sgemm(F, ((bf16*)(F.ws + WS_XN)) + (size_t)MP * D, ((bf16*)(F.ws + WS_WUP)), UPN, D, e); }
        pg8::Gemm g{(const pb*)((bf16*)(F.ws + WS_XN)), (const pb*)((bf16*)(F.ws + WS_WUP)), MP, UPN, D}; pg8::StaticOrder So; So.init(MP, UPN, F.G, (int)blockIdx.x);
        pg8::EpiConvFfn E{(pb*)((bf16*)(F.ws + WS_ACT)), ((float*)(F.ws + WS_SSQ2)), inptr(23), inptr(24), F.out, (float*)(F.ws + WS_GV), (LAS float*)(F.lds + EXCH_OFF)};
        pg8::gemm_phase<pg8::EpiConvFfn, pg8::StaticOrder, true, true, pg8::KCopy>(F.lds, g, So, E, MKCOPY(160, 176));
    }
    SEAM(8);
    if (IN(9)) { p9_conv(F); }
    SEAM(9);
    if (IN(10)) {
        { SEpiResid<false> e{nullptr, ((bf16*)(F.ws + WS_XN)), ((float*)(F.ws + WS_SSQ3))}; sgemm(F, ((bf16*)(F.ws + WS_ACT)) + (size_t)MP * DFF, ((bf16*)(F.ws + WS_WDN)), D, DFF, e); }
        pg8::Gemm g{(const pb*)((bf16*)(F.ws + WS_ACT)), (const pb*)((bf16*)(F.ws + WS_WDN)), MP, D, DFF}; pg8::StaticOrder So; So.init(MP, D, F.G, (int)blockIdx.x);
        pg8::EpiResid<false> E{nullptr, (pb*)((bf16*)(F.ws + WS_XN)), ((float*)(F.ws + WS_SSQ3))};
        pg8::gemm_phase<pg8::EpiResid<false>, pg8::StaticOrder, true, true, pg8::KCopy2>(F.lds, g, So, E, MKCOPY2(336, 88, 424, 44));
    }
    SEAM(10);
    if (IN(11)) { p11_final(F); }
#undef IN
#undef SEAM
}

extern "C" void kernel_launch(void* const* d_in, const int* in_sizes, int n_in, void* d_out, int out_size, void* d_ws, size_t ws_size, hipStream_t stream) {
    static int grid = 0;
    if (grid == 0) {
        if (n_in != 27 || (size_t)out_size != O_END || ws_size < WS_END) { fprintf(stderr, "kernel_launch: unexpected shapes: n_in %d out %d ws %zu\n", n_in, out_size, ws_size); grid = -1; return; }
        int dev = 0, cus = 0, per_cu = 0;
        if (hipGetDevice(&dev) != hipSuccess || hipDeviceGetAttribute(&cus, hipDeviceAttributeMultiprocessorCount, dev) != hipSuccess) { grid = -1; return; }
        if (hipFuncSetAttribute((const void*)fwd, hipFuncAttributeMaxDynamicSharedMemorySize, LDS_BYTES) != hipSuccess) { fprintf(stderr, "kernel_launch: hipFuncSetAttribute failed\n"); grid = -1; return; }
        if (hipOccupancyMaxActiveBlocksPerMultiprocessor(&per_cu, (const void*)fwd, NWAVES * 64, LDS_BYTES) != hipSuccess || per_cu < 1) fprintf(stderr, "kernel_launch: occupancy query reports %d\n", per_cu);
        (void)hipGetLastError();
        grid = cus;
    }
    if (grid < 0) return;
    (void)hipMemsetAsync((char*)d_ws + WS_CTL, 0, CTL_ZERO_BYTES, stream);
    Args a{};
    for (int i = 0; i < 27; ++i) a.in[i] = (const float*)d_in[i];
    a.out = (float*)d_out; a.ws = (unsigned char*)d_ws;
    if (N_LAUNCHES == 1) { a.ph_lo = 0; a.ph_hi = NPH; hipLaunchKernelGGL(fwd, dim3(grid), dim3(NWAVES * 64), LDS_BYTES, stream, a); }
    else for (int p = 0; p < NPH; ++p) { a.ph_lo = p; a.ph_hi = p + 1; hipLaunchKernelGGL(fwd, dim3(grid), dim3(NWAVES * 64), LDS_BYTES, stream, a); }
}
```
